# Optimizing an MI355X kernel written in HIP

```python
import math
import jax, jax.numpy as jnp
from jax import lax
import numpy as np

D_MODEL = 1024
BATCH = 4
SEQ = 4096
DEPTH = 2
DEC_BATCH = 8
DEC_SEQ = 16
PAST_LEN = 2048

CHUNK = 64
QBLOCK = 128
D_PLE = 256
D_FF = 2816
EPS = 1e-6
N_NORMS = 8
N_EVEN = (DEPTH + 1) // 2
N_ODD = DEPTH // 2

SB_HEADS = 8
SB_HD = 64
DF_HEADS = 4
DF_HD = 64
DF_ROT = DF_HD // 4
ROPE_THETA = 500000.0
MLA_HEADS = 16
MLA_NOPE = 64
MLA_ROPE = 32
MLA_VD = 64
Q_LORA = 384
KV_LORA = 256
MLA_THETA = 10000.0

SB_W = SB_HEADS * SB_HD
DF_QK_W = DF_HEADS * 2 * DF_HD
DF_V_W = DF_HEADS * 2 * DF_HD
AB_IN = 3 * SB_W + 2 * DF_QK_W + DF_V_W
AB_OUT = SB_W + DF_V_W
MLA_QD = MLA_NOPE + MLA_ROPE
MLA_IN = Q_LORA + KV_LORA + MLA_ROPE

kernel_name = 'stickbreak_diff_mla_macaron_stream'


def _rms(x, g):
    x32 = x.astype(jnp.float32)
    y = x32 * lax.rsqrt(jnp.mean(x32 * x32, axis=-1, keepdims=True) + EPS)
    return (y * g.astype(jnp.float32)).astype(x.dtype)


def _rope(x, pos, rot, theta):
    half = rot // 2
    inv = jnp.float32(theta) ** (-(jnp.arange(half, dtype=jnp.float32) * (2.0 / rot)))
    ang = pos.astype(jnp.float32)[:, None] * inv[None, :]
    shape = (1, pos.shape[0]) + (1,) * (x.ndim - 3) + (half,)
    cos = jnp.cos(ang).reshape(shape)
    sin = jnp.sin(ang).reshape(shape)
    xf = x.astype(jnp.float32)
    x1 = xf[..., :half]
    x2 = xf[..., half:rot]
    out = jnp.concatenate([x1 * cos - x2 * sin, x2 * cos + x1 * sin, xf[..., rot:]], axis=-1)
    return out.astype(x.dtype)


def _swiglu(x, w_gu, w_dn):
    g, u = jnp.split(x @ w_gu, 2, axis=-1)
    return (jax.nn.silu(g) * u) @ w_dn


def _sweep(block_fn, q_pos, *qs):
    T = q_pos.shape[0]
    qb = QBLOCK if T % QBLOCK == 0 else T
    nb = T // qb

    def split(a):
        return jnp.moveaxis(a.reshape((a.shape[0], nb, qb) + a.shape[2:]), 1, 0)

    out = lax.map(lambda args: block_fn(*args), (q_pos.reshape(nb, qb),) + tuple(split(a) for a in qs))
    out = jnp.moveaxis(out, 0, 1)
    return out.reshape((out.shape[0], T) + out.shape[3:])


def _chunk_visible(pb, k_pos):
    return (k_pos[None, :] // CHUNK) <= (pb[:, None] // CHUNK)


def _stick_breaking(q, k, v, q_pos, k_pos):
    scale = SB_HD ** -0.5

    def block(pb, qb_):
        z = jnp.einsum('bqhd,bkhd->bhqk', qb_, k).astype(jnp.float32) * scale
        earlier = k_pos[None, :] < pb[:, None]
        log_fail = jnp.where(earlier, jax.nn.log_sigmoid(-z), 0.0)
        between = lax.cumsum(log_fail, axis=3, reverse=True) - log_fail
        w = jnp.where(earlier, jnp.exp(jax.nn.log_sigmoid(z) + between), 0.0)
        return jnp.einsum('bhqk,bkhd->bqhd', w.astype(v.dtype), v)

    return _sweep(block, q_pos, q)


def _diff_attn(q, k, v, q_pos, k_pos, lam):
    scale = DF_HD ** -0.5

    def block(pb, qb_):
        s = jnp.einsum('bqhcd,bkhcd->bhcqk', qb_, k).astype(jnp.float32) * scale
        vis = _chunk_visible(pb, k_pos)
        pr = jax.nn.softmax(jnp.where(vis, s, -jnp.inf), axis=-1)
        w = pr[:, :, 0] - lam * pr[:, :, 1]
        return jnp.einsum('bhqk,bkhe->bqhe', w.astype(v.dtype), v)

    return _sweep(block, q_pos, q)


def _mla_attn(q_nope, q_rope, k_nope, k_rope, v, q_pos, k_pos):
    scale = MLA_QD ** -0.5

    def block(pb, qn, qr):
        s = (jnp.einsum('bqhd,bkhd->bhqk', qn, k_nope).astype(jnp.float32)
             + jnp.einsum('bqhr,bkr->bhqk', qr, k_rope).astype(jnp.float32)) * scale
        pr = jax.nn.softmax(jnp.where(_chunk_visible(pb, k_pos), s, -jnp.inf), axis=-1)
        return jnp.einsum('bhqk,bkhd->bqhd', pr.astype(v.dtype), v)

    return _sweep(block, q_pos, q_nope, q_rope)


def _mixer_ab(h, start, layer, w_in, w_out, lam_vecs, subln, cache):
    B, T, _ = h.shape
    pos = start + jnp.arange(T)
    k_pos = jnp.arange(start + T)
    proj = h @ w_in
    cuts = [SB_W, 2 * SB_W, 3 * SB_W, 3 * SB_W + DF_QK_W, 3 * SB_W + 2 * DF_QK_W]
    sb_q, sb_k, sb_v, df_q, df_k, df_v = jnp.split(proj, cuts, axis=-1)
    sb_q = sb_q.reshape(B, T, SB_HEADS, SB_HD)
    sb_k = sb_k.reshape(B, T, SB_HEADS, SB_HD)
    sb_v = sb_v.reshape(B, T, SB_HEADS, SB_HD)
    df_q = _rope(df_q.reshape(B, T, DF_HEADS, 2, DF_HD), pos, DF_ROT, ROPE_THETA)
    df_k = _rope(df_k.reshape(B, T, DF_HEADS, 2, DF_HD), pos, DF_ROT, ROPE_THETA)
    df_v = df_v.reshape(B, T, DF_HEADS, 2 * DF_HD)
    new = (sb_k, sb_v, df_k, df_v)
    if cache is None:
        ks = new
    else:
        ks = tuple(jnp.concatenate([c, n], axis=1) for c, n in zip(cache, new))
    sb_out = _stick_breaking(sb_q, ks[0], ks[1], pos, k_pos)
    lam_init = 0.8 - 0.6 * math.exp(-0.3 * layer)
    lv = lam_vecs.astype(jnp.float32)
    lam = jnp.exp(jnp.dot(lv[0], lv[1])) - jnp.exp(jnp.dot(lv[2], lv[3])) + lam_init
    df_out = _diff_attn(df_q, ks[2], ks[3], pos, k_pos, lam)
    df_out = _rms(df_out, subln) * (1.0 - lam_init)
    merged = jnp.concatenate([sb_out.reshape(B, T, SB_W), df_out.reshape(B, T, DF_V_W)], axis=-1)
    return merged @ w_out, new


def _mixer_mla(h, start, w_in, q_norm, kv_norm, w_uq, w_uk, w_uv, w_out, cache):
    B, T, _ = h.shape
    pos = start + jnp.arange(T)
    k_pos = jnp.arange(start + T)
    c_q, c_kv, k_r = jnp.split(h @ w_in, [Q_LORA, Q_LORA + KV_LORA], axis=-1)
    c_q = _rms(c_q, q_norm)
    c_kv = _rms(c_kv, kv_norm)
    q = (c_q @ w_uq).reshape(B, T, MLA_HEADS, MLA_QD)
    q_nope = q[..., :MLA_NOPE]
    q_rope = _rope(q[..., MLA_NOPE:], pos, MLA_ROPE, MLA_THETA)
    k_r = _rope(k_r, pos, MLA_ROPE, MLA_THETA)
    new = (c_kv, k_r)
    if cache is None:
        lat, kr = new
    else:
        lat = jnp.concatenate([cache[0], c_kv], axis=1)
        kr = jnp.concatenate([cache[1], k_r], axis=1)
    Tk = lat.shape[1]
    k_nope = (lat @ w_uk).reshape(B, Tk, MLA_HEADS, MLA_NOPE)
    v = (lat @ w_uv).reshape(B, Tk, MLA_HEADS, MLA_VD)
    out = _mla_attn(q_nope, q_rope, k_nope, kr, v, pos, k_pos)
    return out.reshape(B, T, MLA_HEADS * MLA_VD) @ w_out, new


def _trunk(x, p, start, caches, W):
    ab_rows, mla_rows = [], []
    for i in range(DEPTH):
        g = W['norms'][i]
        x = x + 0.5 * _rms(_swiglu(_rms(x, g[0]), W['ffn1_gu'][i], W['ffn1_dn'][i]), g[1])
        h = _rms(x, g[2])
        j = i // 2
        if i % 2 == 0:
            c = None if caches is None else tuple(a[j] for a in caches[:4])
            m, rows = _mixer_ab(h, start, i, W['ab_in'][j], W['ab_out'][j], W['df_lambda'][j], W['df_subln'][j], c)
            ab_rows.append(rows)
        else:
            c = None if caches is None else tuple(a[j] for a in caches[4:])
            m, rows = _mixer_mla(h, start, W['mla_in'][j], W['mla_q_norm'][j], W['mla_kv_norm'][j],
                                 W['mla_uq'][j], W['mla_uk'][j], W['mla_uv'][j], W['mla_out'][j], c)
            mla_rows.append(rows)
        x = x + _rms(m, g[3])
        x = x + 0.5 * _rms(_swiglu(_rms(x, g[4]), W['ffn2_gu'][i], W['ffn2_dn'][i]), g[5])
        gate = jax.nn.sigmoid(_rms(x, g[6]) @ W['ple_gate'][i])
        x = x + _rms(gate * (p[i] @ W['ple_in'][i]), g[7])
    sb_k, sb_v, df_k, df_v = [jnp.stack(r, axis=0) for r in zip(*ab_rows)]
    lat, kr = [jnp.stack(r, axis=0) for r in zip(*mla_rows)]
    return x, sb_k, sb_v, df_k, df_v, lat, kr


def setup_inputs(seed: int = 0) -> dict:
    key = jax.random.key(seed)
    ks = jax.random.split(key, 32)
    f32 = jnp.float32

    def w(k, shape, fan_in):
        return jax.random.normal(k, shape, f32) * (fan_in ** -0.5)

    def gain(k, shape):
        return 1.0 + 0.05 * jax.random.normal(k, shape, f32)

    return {
        'x_prompt': jax.random.normal(ks[0], (BATCH, SEQ, D_MODEL), f32),
        'x_sample': jax.random.normal(ks[1], (DEC_BATCH, DEC_SEQ, D_MODEL), f32),
        'p_prompt': jax.random.normal(ks[2], (DEPTH, BATCH, SEQ, D_PLE), f32),
        'p_sample': jax.random.normal(ks[3], (DEPTH, DEC_BATCH, DEC_SEQ, D_PLE), f32),
        'cache_sb_k': jax.random.normal(ks[4], (N_EVEN, DEC_BATCH, PAST_LEN, SB_HEADS, SB_HD), f32),
        'cache_sb_v': jax.random.normal(ks[5], (N_EVEN, DEC_BATCH, PAST_LEN, SB_HEADS, SB_HD), f32),
        'cache_df_k': jax.random.normal(ks[6], (N_EVEN, DEC_BATCH, PAST_LEN, DF_HEADS, 2, DF_HD), f32),
        'cache_df_v': jax.random.normal(ks[7], (N_EVEN, DEC_BATCH, PAST_LEN, DF_HEADS, 2 * DF_HD), f32),
        'cache_mla_latent': jax.random.normal(ks[8], (N_ODD, DEC_BATCH, PAST_LEN, KV_LORA), f32),
        'cache_mla_krope': jax.random.normal(ks[9], (N_ODD, DEC_BATCH, PAST_LEN, MLA_ROPE), f32),
        'norms': gain(ks[10], (DEPTH, N_NORMS, D_MODEL)),
        'ffn1_gu': w(ks[11], (DEPTH, D_MODEL, 2 * D_FF), D_MODEL),
        'ffn1_dn': w(ks[12], (DEPTH, D_FF, D_MODEL), D_FF),
        'ffn2_gu': w(ks[13], (DEPTH, D_MODEL, 2 * D_FF), D_MODEL),
        'ffn2_dn': w(ks[14], (DEPTH, D_FF, D_MODEL), D_FF),
        'ple_in': w(ks[15], (DEPTH, D_PLE, D_MODEL), D_PLE),
        'ple_gate': w(ks[16], (DEPTH, D_MODEL, D_MODEL), D_MODEL),
        'ab_in': w(ks[17], (N_EVEN, D_MODEL, AB_IN), D_MODEL),
        'ab_out': w(ks[18], (N_EVEN, AB_OUT, D_MODEL), AB_OUT),
        'df_lambda': 0.1 * jax.random.normal(ks[19], (N_EVEN, 4, DF_HD), f32),
        'df_subln': gain(ks[20], (N_EVEN, 2 * DF_HD)),
        'mla_in': w(ks[21], (N_ODD, D_MODEL, MLA_IN), D_MODEL),
        'mla_q_norm': gain(ks[22], (N_ODD, Q_LORA)),
        'mla_kv_norm': gain(ks[23], (N_ODD, KV_LORA)),
        'mla_uq': w(ks[24], (N_ODD, Q_LORA, MLA_HEADS * MLA_QD), Q_LORA),
        'mla_uk': w(ks[25], (N_ODD, KV_LORA, MLA_HEADS * MLA_NOPE), KV_LORA),
        'mla_uv': w(ks[26], (N_ODD, KV_LORA, MLA_HEADS * MLA_VD), KV_LORA),
        'mla_out': w(ks[27], (N_ODD, MLA_HEADS * MLA_VD, D_MODEL), MLA_HEADS * MLA_VD),
    }


def reference(x_prompt, x_sample, p_prompt, p_sample, cache_sb_k, cache_sb_v, cache_df_k, cache_df_v,
              cache_mla_latent, cache_mla_krope, norms, ffn1_gu, ffn1_dn, ffn2_gu, ffn2_dn, ple_in, ple_gate,
              ab_in, ab_out, df_lambda, df_subln, mla_in, mla_q_norm, mla_kv_norm, mla_uq, mla_uk, mla_uv, mla_out):
    W = dict(norms=norms, ffn1_gu=ffn1_gu, ffn1_dn=ffn1_dn, ffn2_gu=ffn2_gu, ffn2_dn=ffn2_dn,
             ple_in=ple_in, ple_gate=ple_gate, ab_in=ab_in, ab_out=ab_out, df_lambda=df_lambda,
             df_subln=df_subln, mla_in=mla_in, mla_q_norm=mla_q_norm, mla_kv_norm=mla_kv_norm,
             mla_uq=mla_uq, mla_uk=mla_uk, mla_uv=mla_uv, mla_out=mla_out)
    (y_prompt, sb_k_p, sb_v_p, df_k_p, df_v_p, lat_p, kr_p) = _trunk(x_prompt, p_prompt, 0, None, W)
    caches = (cache_sb_k, cache_sb_v, cache_df_k, cache_df_v, cache_mla_latent, cache_mla_krope)
    past = cache_sb_k.shape[2]
    (y_sample, sb_k_s, sb_v_s, df_k_s, df_v_s, lat_s, kr_s) = _trunk(x_sample, p_sample, past, caches, W)
    return (y_prompt, y_sample, sb_k_p, sb_v_p, df_k_p, df_v_p, lat_p, kr_p,
            sb_k_s, sb_v_s, df_k_s, df_v_s, lat_s, kr_s)
```

```cpp
#include <hip/hip_runtime.h>
#include <hip/hip_cooperative_groups.h>
#include <cstdio>
#include <cstdint>
#include <cmath>
namespace cg = cooperative_groups;

template <int MASK> __device__ __forceinline__ float shx(float v) {
    static_assert(MASK > 0 && MASK < 32, "shx: xor mask 1..31");
    return __builtin_bit_cast(float, __builtin_amdgcn_ds_swizzle(__builtin_bit_cast(int, v), (MASK << 10) | 0x1F));
}
__device__ __forceinline__ float shx32(float v, int lane) {
    return __builtin_bit_cast(float, __builtin_amdgcn_ds_bpermute((lane ^ 32) << 2, __builtin_bit_cast(int, v)));
}
__device__ __forceinline__ float sum32(float v, int lane) { return v + shx32(v, lane); }
__device__ __forceinline__ float max32(float v, int lane) { return fmaxf(v, shx32(v, lane)); }
namespace pg8 {
#define PG8_LAS __attribute__((address_space(3)))
typedef unsigned short bf16_t;
typedef short bf16x8 __attribute__((ext_vector_type(8)));
typedef float f32x4 __attribute__((ext_vector_type(4)));
typedef unsigned u32x4 __attribute__((ext_vector_type(4)));
constexpr int BM = 256, BK = 64, HALF = 128, HTB = HALF * BK * 2  , STAGE_BYTES = 8 * HTB, NXCD = 8, WGM = 8;

__host__ __device__ __forceinline__ int lds_byte(int r, int c) { const int st = (r >> 4) * 2 + (c >> 5), rr = r & 15, cc = c & 31, ob = rr * 64 + cc * 2; return st * 1024 + (ob ^ (((ob >> 9) & 1) << 5)); }
__host__ __device__ __forceinline__ void stage_rc(int b, int& R, int& C) { const int st = b / 1024, sb = b % 1024, swz = sb ^ (((sb >> 9) & 1) << 5); R = (st >> 1) * 16 + swz / 64; C = (st & 1) * 32 + (swz % 64) / 2; }
__host__ __device__ __forceinline__ int perm32(int rho) { const int n = rho >> 4, i = rho & 15; return 8 * (i >> 2) + 4 * n + (i & 3); }

struct Unit { int pm, pn, ko; };
struct Gemm { const bf16_t* A; const bf16_t* Bt; int M, N, K, ld; };

struct StaticOrder {
    int nM, nN, nwg, G, c;
    __host__ __device__ void init(int M, int N, int G_, int c_) { nM = M / BM; nN = N / BM; nwg = nM * nN; G = G_; c = c_; }
    __host__ __device__ bool next(int i, Unit& u) const {
        const long L = (long)i * G + c; if (L >= nwg) return false;
        int wgid = (int)L; { const int q = nwg / NXCD, r = nwg % NXCD, xcd = wgid % NXCD, off = wgid / NXCD; wgid = (xcd < r ? xcd * (q + 1) : r * (q + 1) + (xcd - r) * q) + off; }
        const int nig = WGM * nN, gid = wgid / nig, fm = gid * WGM, gsz = (nM - fm) < WGM ? (nM - fm) : WGM;
        u.pm = fm + ((wgid % nig) % gsz); u.pn = (wgid % nig) / gsz; u.ko = 0; return true;
    }
    __device__ __forceinline__ void a_ready(const Unit&) const {}
    __device__ __forceinline__ void done(const Unit&) const {}
};


struct SplitOrder {
    int nN, KS, G, c, pmfix, kslice2;
    __host__ __device__ void init(int N, int KS_, int pmfix_, int kslice_elems, int G_, int c_) { nN = N / BM; KS = KS_; G = G_; c = c_; pmfix = pmfix_; kslice2 = kslice_elems * 2; }
    __host__ __device__ bool next(int i, Unit& u) const { const int L = i * G + c; if (L >= nN * KS) return false; u.pm = pmfix; u.pn = L % nN; u.ko = (L / nN) * kslice2; return true; }
    __device__ __forceinline__ void a_ready(const Unit&) const {}
    __device__ __forceinline__ void done(const Unit&) const {}
};
__device__ __forceinline__ unsigned cvt_pk_bf16(float lo, float hi) { unsigned r; asm volatile("v_cvt_pk_bf16_f32 %0, %1, %2" : "=v"(r) : "v"(lo), "v"(hi)); return r; }
typedef float f32x2 __attribute__((ext_vector_type(2)));
typedef unsigned u32x2 __attribute__((ext_vector_type(2)));
constexpr int TOK_P = 16384, TOK_ALL = 16512;
constexpr float LOG2E = 1.4426950408889634f;

struct EpiF32 {
    static constexpr bool PERM = true, AFTER_DRAIN = false;
    float* O; int ldc;
    __device__ __forceinline__ void operator()(const f32x4 (&acc)[2][2][4][2], const Unit& u, int wr, int wc, int fr, int fq) const {
        const int row0 = u.pm * BM + wr * 64 + fr, col0 = u.pn * BM + wc * 32 + 8 * fq;
#pragma unroll
        for (int ai = 0; ai < 2; ++ai)
#pragma unroll
            for (int m = 0; m < 4; ++m) { float* rowp = O + (size_t)(row0 + ai * HALF + m * 16) * ldc + col0;
#pragma unroll
                for (int bj = 0; bj < 2; ++bj) { *(f32x4*)(rowp + bj * HALF) = acc[ai][bj][m][0]; *(f32x4*)(rowp + bj * HALF + 4) = acc[ai][bj][m][1]; } }
    }
};
struct EpiPart {
    static constexpr bool PERM = true, AFTER_DRAIN = false;
    float* P; int ldc; int kslice2;
    __device__ __forceinline__ void operator()(const f32x4 (&acc)[2][2][4][2], const Unit& u, int wr, int wc, int fr, int fq) const {
        const int row0 = wr * 64 + fr, col0 = u.pn * BM + wc * 32 + 8 * fq; float* O = P + (size_t)(u.ko / kslice2) * 256 * ldc;
#pragma unroll
        for (int ai = 0; ai < 1; ++ai)
#pragma unroll
            for (int m = 0; m < 4; ++m) { float* rowp = O + (size_t)(row0 + ai * HALF + m * 16) * ldc + col0;
#pragma unroll
                for (int bj = 0; bj < 2; ++bj) { *(f32x4*)(rowp + bj * HALF) = acc[ai][bj][m][0]; *(f32x4*)(rowp + bj * HALF + 4) = acc[ai][bj][m][1]; } }
    }
};
struct EpiBf16Split {
    static constexpr bool PERM = true, AFTER_DRAIN = false;
    bf16_t* O0; bf16_t* O1; int ldc; int split; float sc;
    __device__ __forceinline__ void operator()(const f32x4 (&acc)[2][2][4][2], const Unit& u, int wr, int wc, int fr, int fq) const {
        int colt = u.pn * BM; bf16_t* base = O0; if (colt >= split) { base = O1; colt -= split; }
        const int row0 = u.pm * BM + wr * 64 + fr, col0 = colt + wc * 32 + 8 * fq;
#pragma unroll
        for (int ai = 0; ai < 2; ++ai)
#pragma unroll
            for (int m = 0; m < 4; ++m) { bf16_t* rowp = base + (size_t)(row0 + ai * HALF + m * 16) * ldc + col0;
#pragma unroll
                for (int bj = 0; bj < 2; ++bj) { const f32x4 v0 = acc[ai][bj][m][0] * sc, v1 = acc[ai][bj][m][1] * sc;
                    u32x4 w; w.x = cvt_pk_bf16(v0[0], v0[1]); w.y = cvt_pk_bf16(v0[2], v0[3]); w.z = cvt_pk_bf16(v1[0], v1[1]); w.w = cvt_pk_bf16(v1[2], v1[3]);
                    *(u32x4*)(rowp + bj * HALF) = w; } }
    }
};
struct EpiSwiglu {
    static constexpr bool PERM = true, AFTER_DRAIN = false;
    bf16_t* O; int ldc;
    __device__ __forceinline__ void operator()(const f32x4 (&acc)[2][2][4][2], const Unit& u, int wr, int wc, int fr, int fq) const {
        const int row0 = u.pm * BM + wr * 64 + fr, col0 = u.pn * 128 + wc * 16 + 4 * fq;
#pragma unroll
        for (int ai = 0; ai < 2; ++ai)
#pragma unroll
            for (int m = 0; m < 4; ++m) { bf16_t* rowp = O + (size_t)(row0 + ai * HALF + m * 16) * ldc + col0;
#pragma unroll
                for (int bj = 0; bj < 2; ++bj) { const f32x4 g = acc[ai][bj][m][0], uu = acc[ai][bj][m][1]; float v[4];
#pragma unroll
                    for (int j = 0; j < 4; ++j) v[j] = g[j] * __builtin_amdgcn_rcpf(1.0f + __builtin_amdgcn_exp2f(-g[j] * LOG2E)) * uu[j];
                    u32x2 w; w.x = cvt_pk_bf16(v[0], v[1]); w.y = cvt_pk_bf16(v[2], v[3]);
                    *(u32x2*)(rowp + bj * 64) = w; } }
    }
};
struct EpiGateMul {
    static constexpr bool PERM = true, AFTER_DRAIN = false;
    float* O; int ldc;
    __device__ __forceinline__ void operator()(const f32x4 (&acc)[2][2][4][2], const Unit& u, int wr, int wc, int fr, int fq) const {
        const int row0 = u.pm * BM + wr * 64 + fr, col0 = u.pn * BM + wc * 32 + 8 * fq;
#pragma unroll
        for (int ai = 0; ai < 2; ++ai)
#pragma unroll
            for (int m = 0; m < 4; ++m) { float* rowp = O + (size_t)(row0 + ai * HALF + m * 16) * ldc + col0;
#pragma unroll
                for (int bj = 0; bj < 2; ++bj)
#pragma unroll
                    for (int n = 0; n < 2; ++n) { f32x4 o = *(f32x4*)(rowp + bj * HALF + 4 * n); const f32x4 a = acc[ai][bj][m][n];
#pragma unroll
                        for (int j = 0; j < 4; ++j) o[j] *= __builtin_amdgcn_rcpf(1.0f + __builtin_amdgcn_exp2f(-a[j] * LOG2E));
                        *(f32x4*)(rowp + bj * HALF + 4 * n) = o; } }
    }
};
__device__ __forceinline__ int tok_pos(int row) { return row < TOK_P ? (row & 4095) : 2048 + ((row - TOK_P) & 15); }
struct EpiAbIn {
    static constexpr bool PERM = true, AFTER_DRAIN = false;
    float* out;
    bf16_t* q;
    bf16_t* kvp;
    bf16_t* kvs;
    const float* rope;
    long offp, offs;
    float qscale;
    __device__ __forceinline__ void operator()(const f32x4 (&acc)[2][2][4][2], const Unit& u, int wr, int wc, int fr, int fq) const {
        const int seg = u.pn >> 1;
        const int row0 = u.pm * BM + wr * 64 + fr, cs0 = (u.pn & 1) * 256 + wc * 32 + 8 * fq;
        const bool rot = (seg == 3 || seg == 4), isq = (seg == 0 || seg == 3);
        const bool rlane = ((wc & 1) == 0) && (fq < 2);
        const int kvi = (seg == 1) ? 0 : (seg == 2) ? 1 : (seg == 4) ? 2 : 3;
#pragma unroll
        for (int ai = 0; ai < 2; ++ai)
#pragma unroll
            for (int m = 0; m < 4; ++m) {
                const int row = row0 + ai * HALF + m * 16; const int pos = tok_pos(row);
                f32x4 cs_[4];
                if (rot) { const f32x4* rp = (const f32x4*)(rope + (size_t)pos * 16); cs_[0] = rp[0]; cs_[1] = rp[1]; cs_[2] = rp[2]; cs_[3] = rp[3]; }
#pragma unroll
                for (int bj = 0; bj < 2; ++bj) {
                    f32x4 v[2] = {acc[ai][bj][m][0], acc[ai][bj][m][1]};
                    if (rot) {
#pragma unroll
                        for (int n = 0; n < 2; ++n)
#pragma unroll
                            for (int j = 0; j < 4; ++j) { const float own = v[n][j], oth = shx<16>(own); const float c = cs_[n][j], s = cs_[2 + n][j];
                                const float r = (fq == 0) ? own * c - oth * s : own * c + oth * s; if (rlane) v[n][j] = r; }
                    }
                    const int cs = cs0 + bj * 128;
                    if (isq) {
                        bf16_t* qp = q + (seg == 0 ? (size_t)0 : (size_t)16640 * 512) + (size_t)row * 512 + cs;
                        u32x4 w; w.x = cvt_pk_bf16(v[0][0] * qscale, v[0][1] * qscale); w.y = cvt_pk_bf16(v[0][2] * qscale, v[0][3] * qscale);
                        w.z = cvt_pk_bf16(v[1][0] * qscale, v[1][1] * qscale); w.w = cvt_pk_bf16(v[1][2] * qscale, v[1][3] * qscale);
                        *(u32x4*)qp = w;
                    } else if (row < TOK_ALL) {
                        float* op; bf16_t* bp;
                        if (row < TOK_P) { op = out + offp + (size_t)kvi * 8388608 + (size_t)row * 512 + cs; bp = kvp + (size_t)kvi * (16384 * 512) + (size_t)row * 512 + cs; }
                        else { const int rs = row - TOK_P; op = out + offs + (size_t)kvi * 65536 + (size_t)rs * 512 + cs; bp = kvs + (size_t)kvi * (8 * 2112 * 512) + ((size_t)(rs >> 4) * 2112 + 2048 + (rs & 15)) * 512 + cs; }
                        __builtin_nontemporal_store(v[0], (f32x4*)op); __builtin_nontemporal_store(v[1], (f32x4*)(op + 4));
                        u32x4 w; w.x = cvt_pk_bf16(v[0][0], v[0][1]); w.y = cvt_pk_bf16(v[0][2], v[0][3]); w.z = cvt_pk_bf16(v[1][0], v[1][1]); w.w = cvt_pk_bf16(v[1][2], v[1][3]);
                        *(u32x4*)bp = w;
                    }
                }
            }
    }
};

struct RowStat {
    unsigned* xbuf;
    unsigned* cnt;
    unsigned want;
    float inv_n, eps;
    __device__ __forceinline__ void run(const f32x4 (&v)[2][2][4][2], const Unit& u, int wr, int wc, int fr, int fq, PG8_LAS unsigned char* lds, int wid, int lane) const {
        PG8_LAS float* P = (PG8_LAS float*)lds;
        PG8_LAS float* S = (PG8_LAS float*)(lds + 8192);
#pragma unroll
        for (int ai = 0; ai < 2; ++ai)
#pragma unroll
            for (int m = 0; m < 4; ++m) { float s = 0.f;
#pragma unroll
                for (int bj = 0; bj < 2; ++bj)
#pragma unroll
                    for (int n = 0; n < 2; ++n) { const f32x4 x = v[ai][bj][m][n]; s += (x[0] * x[0] + x[1] * x[1]) + (x[2] * x[2] + x[3] * x[3]); }
                s += shx<16>(s); s += shx32(s, lane);
                if (fq == 0) P[(ai * HALF + wr * 64 + m * 16 + fr) * 4 + wc] = s; }
        asm volatile("s_waitcnt lgkmcnt(0)" ::: "memory"); __builtin_amdgcn_s_barrier(); asm volatile("" ::: "memory");
        const int row = wid * 32 + (lane & 31);
        if (lane < 32) { const float t = (P[row * 4 + 0] + P[row * 4 + 1]) + (P[row * 4 + 2] + P[row * 4 + 3]);
            __hip_atomic_store(xbuf + ((size_t)(u.pm * BM + row) * 4 + u.pn), __builtin_bit_cast(unsigned, t), __ATOMIC_RELAXED, __HIP_MEMORY_SCOPE_AGENT); }
        asm volatile("s_waitcnt vmcnt(0)" ::: "memory");
        if (lane == 0) __hip_atomic_fetch_add(cnt + 64 * u.pm, 1u, __ATOMIC_RELAXED, __HIP_MEMORY_SCOPE_AGENT);
        if (wid == 0) {
            unsigned sp = 0;
            for (;;) {
                if ((unsigned)__builtin_amdgcn_readfirstlane(__hip_atomic_load(cnt + 64 * u.pm, __ATOMIC_RELAXED, __HIP_MEMORY_SCOPE_AGENT)) >= want) break;
                if (++sp > (1u << 22)) break;
                __builtin_amdgcn_s_sleep(2);
            }
            __builtin_amdgcn_fence(__ATOMIC_ACQUIRE, "agent");
        }
        asm volatile("s_waitcnt vmcnt(0) lgkmcnt(0)" ::: "memory"); __builtin_amdgcn_s_barrier(); asm volatile("" ::: "memory");
        if (lane < 32) { const unsigned* slot = xbuf + (size_t)(u.pm * BM + row) * 4; float t = 0.f;
#pragma unroll
            for (int q = 0; q < 4; ++q) t += __builtin_bit_cast(float, __hip_atomic_load(slot + q, __ATOMIC_RELAXED, __HIP_MEMORY_SCOPE_AGENT));
            S[row] = 1.0f / sqrtf(t * inv_n + eps); }
        asm volatile("s_waitcnt lgkmcnt(0)" ::: "memory"); __builtin_amdgcn_s_barrier(); asm volatile("" ::: "memory");
    }
};
template <bool GATE, bool HASB> struct EpiRms2 {
    static constexpr bool PERM = true, AFTER_DRAIN = true;
    const float* base; float* out; bf16_t* xn; const float* pin; const float* ga; const float* gb; float coef; RowStat st1, st2;
    __device__ __forceinline__ void fused(f32x4 (&acc)[2][2][4][2], const Unit& u, int wr, int wc, int fr, int fq, PG8_LAS unsigned char* lds, int wid, int lane) const {
        const PG8_LAS float* S = (const PG8_LAS float*)(lds + 8192);
        const int col0 = u.pn * BM + wc * 32 + 8 * fq;
        if (GATE) {
#pragma unroll
            for (int ai = 0; ai < 2; ++ai)
#pragma unroll
                for (int m = 0; m < 4; ++m) { const size_t off = (size_t)(u.pm * BM + ai * HALF + wr * 64 + m * 16 + fr) * 1024 + col0;
#pragma unroll
                    for (int bj = 0; bj < 2; ++bj) {
                        const f32x4 p0 = *(const f32x4*)(pin + off + bj * HALF), p1 = *(const f32x4*)(pin + off + bj * HALF + 4);
                        f32x4 a0 = acc[ai][bj][m][0], a1 = acc[ai][bj][m][1];
#pragma unroll
                        for (int j = 0; j < 4; ++j) { a0[j] = p0[j] * __builtin_amdgcn_rcpf(1.0f + __builtin_amdgcn_exp2f(-a0[j] * LOG2E)); a1[j] = p1[j] * __builtin_amdgcn_rcpf(1.0f + __builtin_amdgcn_exp2f(-a1[j] * LOG2E)); }
                        acc[ai][bj][m][0] = a0; acc[ai][bj][m][1] = a1;
                        asm volatile("" : "+v"(acc[ai][bj][m][0]), "+v"(acc[ai][bj][m][1]) :: "memory");
                    } }
        }
        st1.run(acc, u, wr, wc, fr, fq, lds, wid, lane);
        {   f32x4 g[2][2];
#pragma unroll
            for (int bj = 0; bj < 2; ++bj)
#pragma unroll
                for (int n = 0; n < 2; ++n) g[bj][n] = *(const f32x4*)(ga + col0 + bj * HALF + 4 * n) * coef;
#pragma unroll
            for (int ai = 0; ai < 2; ++ai)
#pragma unroll
                for (int m = 0; m < 4; ++m) { const int r = ai * HALF + wr * 64 + m * 16 + fr; const float s1 = S[r]; const size_t off = (size_t)(u.pm * BM + r) * 1024 + col0;
#pragma unroll
                    for (int bj = 0; bj < 2; ++bj)
#pragma unroll
                        for (int n = 0; n < 2; ++n) { const f32x4 b = *(const f32x4*)(base + off + bj * HALF + 4 * n); acc[ai][bj][m][n] = b + acc[ai][bj][m][n] * g[bj][n] * s1; }
                    asm volatile("" : "+v"(acc[ai][0][m][0]), "+v"(acc[ai][0][m][1]), "+v"(acc[ai][1][m][0]), "+v"(acc[ai][1][m][1]));
                    if (m & 1) asm volatile("" ::: "memory"); }
        }
        if (HASB) st2.run(acc, u, wr, wc, fr, fq, lds, wid, lane);
        {   f32x4 g[2][2];
            if (HASB) {
#pragma unroll
                for (int bj = 0; bj < 2; ++bj)
#pragma unroll
                    for (int n = 0; n < 2; ++n) g[bj][n] = *(const f32x4*)(gb + col0 + bj * HALF + 4 * n);
            }
#pragma unroll
            for (int ai = 0; ai < 2; ++ai)
#pragma unroll
                for (int m = 0; m < 4; ++m) { const int r = ai * HALF + wr * 64 + m * 16 + fr; const float s2 = HASB ? S[r] : 0.f; const size_t off = (size_t)(u.pm * BM + r) * 1024 + col0;
#pragma unroll
                    for (int bj = 0; bj < 2; ++bj) { const f32x4 x0 = acc[ai][bj][m][0], x1 = acc[ai][bj][m][1];
                        *(f32x4*)(out + off + bj * HALF) = x0; *(f32x4*)(out + off + bj * HALF + 4) = x1;
                        if (HASB) { const f32x4 y0 = x0 * g[bj][0] * s2, y1 = x1 * g[bj][1] * s2;
                            u32x4 w; w.x = cvt_pk_bf16(y0[0], y0[1]); w.y = cvt_pk_bf16(y0[2], y0[3]); w.z = cvt_pk_bf16(y1[0], y1[1]); w.w = cvt_pk_bf16(y1[2], y1[3]);
                            *(u32x4*)(xn + off + bj * HALF) = w; } }
                    asm volatile("" ::: "memory"); }
        }
        asm volatile("s_waitcnt lgkmcnt(0)" ::: "memory"); __builtin_amdgcn_s_barrier(); asm volatile("" ::: "memory");
    }
};
template <class Epi, class Sched, bool ALIGN_EPI = false, bool SP2 = false>
__device__ __forceinline__ void gemm_phase(PG8_LAS unsigned char* lds, const Gemm g, const Sched& S, const Epi& E) {
    int tid = threadIdx.x; asm volatile("" : "+v"(tid));
    const int wid = __builtin_amdgcn_readfirstlane(tid >> 6), lane = tid & 63, wr = wid >> 2, wc = wid & 3, fr = lane & 15, fq = lane >> 4;
    const int K = g.ld, nt = g.K / BK;
    unsigned voffA[2], voffB[2];
#pragma unroll
    for (int i = 0; i < 2; ++i) { int R, C; stage_rc(tid * 16 + i * 8192, R, C); const int Rb = Epi::PERM ? ((R & ~31) + perm32(R & 31)) : R;
        voffA[i] = (unsigned)(R * K + C) * 2u; voffB[i] = (unsigned)(Rb * K + C) * 2u; }
    const size_t kstep = (size_t)(BK * 2);
    const size_t hstep = (size_t)HALF * K * 2;
    const size_t tstep = 2 * hstep;
    const unsigned ldsw = (unsigned)wid * 1024u;
    const int aoff = lds_byte(wr * 64 + fr, fq * 8), boff = lds_byte(wc * 32 + fr, fq * 8);
#define PG8_SA(b, h) (((b) * 2 + (h)) * HTB)
#define PG8_SB(b, h) ((4 + (b) * 2 + (h)) * HTB)
#define PG8_STAGE(bufoff, gbase, voff) do { _Pragma("unroll") for (int _i = 0; _i < 2; ++_i) \
        __builtin_amdgcn_global_load_lds((const unsigned*)((const char*)(gbase) + (voff)[_i]), (PG8_LAS unsigned*)(lds + (bufoff) + ldsw + _i * 8192), 16, 0, 0); } while (0)
#define PG8_LDA(dst, b, h) do { _Pragma("unroll") for (int m = 0; m < 4; ++m) _Pragma("unroll") for (int k = 0; k < 2; ++k) dst[m][k] = *(const PG8_LAS bf16x8*)(lds + PG8_SA(b, h) + aoff + m * 2048 + k * 1024); } while (0)
#define PG8_LDB(dst, b, h) do { _Pragma("unroll") for (int n = 0; n < 2; ++n) _Pragma("unroll") for (int k = 0; k < 2; ++k) dst[n][k] = *(const PG8_LAS bf16x8*)(lds + PG8_SB(b, h) + boff + n * 2048 + k * 1024); } while (0)
#define PG8_MMA(ai, bj, At, Bt) do { __builtin_amdgcn_s_setprio(1); _Pragma("unroll") for (int m = 0; m < 4; ++m) _Pragma("unroll") for (int n = 0; n < 2; ++n) _Pragma("unroll") for (int k = 0; k < 2; ++k) \
        acc[ai][bj][m][n] = __builtin_amdgcn_mfma_f32_16x16x32_bf16(Bt[n][k], At[m][k], acc[ai][bj][m][n], 0, 0, 0); __builtin_amdgcn_s_setprio(0); } while (0)
#define PG8_WAIT_V(n) asm volatile("s_waitcnt vmcnt(" #n ")" ::: "memory")
#define PG8_WAIT_L(n) asm volatile("s_waitcnt lgkmcnt(" #n ")" ::: "memory")
#define PG8_BAR __builtin_amdgcn_s_barrier()
#define PG8_SCHED __builtin_amdgcn_sched_barrier(0)
    Unit cur, nxt; int ui = 0;
    if (!S.next(0, cur)) return;
    f32x4 acc[2][2][4][2];
#pragma unroll
    for (int a = 0; a < 2; ++a)
#pragma unroll
        for (int b = 0; b < 2; ++b)
#pragma unroll
            for (int m = 0; m < 4; ++m)
#pragma unroll
                for (int n = 0; n < 2; ++n) acc[a][b][m][n] = (f32x4){0.f, 0.f, 0.f, 0.f};
    bf16x8 At[4][2], B0[2][2], B1[2][2];
    const char* cA = (const char*)g.A + (size_t)cur.pm * tstep + cur.ko; const char* cB = (const char*)g.Bt + (size_t)cur.pn * tstep + cur.ko;
    S.a_ready(cur);
    if constexpr (SP2) {
        PG8_STAGE(PG8_SB(0, 0), cB, voffB); PG8_STAGE(PG8_SB(0, 1), cB + hstep, voffB); PG8_STAGE(PG8_SA(0, 0), cA, voffA); PG8_STAGE(PG8_SA(0, 1), cA + hstep, voffA);
        if (wr == 1) PG8_BAR;
        PG8_WAIT_V(2); PG8_BAR;
        PG8_STAGE(PG8_SB(1, 0), cB + kstep, voffB); PG8_STAGE(PG8_SA(1, 0), cA + kstep, voffA); PG8_STAGE(PG8_SB(1, 1), cB + hstep + kstep, voffB);
        PG8_WAIT_V(6); PG8_BAR;
    } else {
        PG8_STAGE(PG8_SB(0, 0), cB, voffB); PG8_STAGE(PG8_SA(0, 0), cA, voffA); PG8_STAGE(PG8_SB(0, 1), cB + hstep, voffB); PG8_STAGE(PG8_SA(0, 1), cA + hstep, voffA);
        if (wr == 1) PG8_BAR;
        PG8_WAIT_V(4); PG8_BAR;
        PG8_STAGE(PG8_SB(1, 0), cB + kstep, voffB); PG8_STAGE(PG8_SA(1, 0), cA + kstep, voffA); PG8_STAGE(PG8_SB(1, 1), cB + hstep + kstep, voffB);
        PG8_WAIT_V(6); PG8_BAR;
    }
    for (;;) {
        const bool has_next = S.next(ui + 1, nxt);
        const char* nA = has_next ? (const char*)g.A + (size_t)nxt.pm * tstep + nxt.ko : cA; const char* nB = has_next ? (const char*)g.Bt + (size_t)nxt.pn * tstep + nxt.ko : cB;
        for (int t = 0; t < nt; t += 2) {
            const bool last = (t == nt - 2);
            const char* a1 = cA + (size_t)(t + 1) * kstep;
            const char* a2 = last ? nA : cA + (size_t)(t + 2) * kstep; const char* b2 = last ? nB : cB + (size_t)(t + 2) * kstep;
            const char* a3 = a2 + kstep; const char* b3 = b2 + kstep;
            if (last && has_next) S.a_ready(nxt);
            if constexpr (SP2) {
            PG8_LDB(B0, 0, 0); PG8_LDB(B1, 0, 1); PG8_SCHED; PG8_LDA(At, 0, 0); PG8_STAGE(PG8_SA(1, 1), a1 + hstep, voffA);
            PG8_WAIT_V(8); PG8_WAIT_L(0); PG8_BAR; PG8_MMA(0, 0, At, B0); PG8_MMA(0, 1, At, B1); PG8_BAR; PG8_SCHED;
            PG8_LDA(At, 0, 1); PG8_STAGE(PG8_SB(0, 0), b2, voffB); PG8_STAGE(PG8_SB(0, 1), b2 + hstep, voffB); PG8_STAGE(PG8_SA(0, 0), a2, voffA);
            PG8_WAIT_V(8); PG8_WAIT_L(0); PG8_BAR; PG8_MMA(1, 0, At, B0); PG8_MMA(1, 1, At, B1); PG8_BAR; PG8_SCHED;
            PG8_LDB(B0, 1, 0); PG8_LDB(B1, 1, 1); PG8_SCHED; PG8_LDA(At, 1, 0); PG8_STAGE(PG8_SA(0, 1), a2 + hstep, voffA);
            PG8_WAIT_V(8); PG8_WAIT_L(0); PG8_BAR; PG8_MMA(0, 0, At, B0); PG8_MMA(0, 1, At, B1); PG8_BAR; PG8_SCHED;
            PG8_LDA(At, 1, 1); PG8_STAGE(PG8_SB(1, 0), b3, voffB); PG8_STAGE(PG8_SB(1, 1), b3 + hstep, voffB); PG8_STAGE(PG8_SA(1, 0), a3, voffA);
            PG8_WAIT_V(8); PG8_WAIT_L(0); PG8_BAR; PG8_MMA(1, 0, At, B0); PG8_MMA(1, 1, At, B1); PG8_BAR; PG8_SCHED;
            } else {
            PG8_LDB(B0, 0, 0); PG8_SCHED; PG8_LDA(At, 0, 0); PG8_STAGE(PG8_SA(1, 1), a1 + hstep, voffA);
            PG8_WAIT_L(8); PG8_BAR; PG8_WAIT_L(0); PG8_MMA(0, 0, At, B0); PG8_BAR; PG8_SCHED;
            PG8_LDB(B1, 0, 1); PG8_STAGE(PG8_SB(0, 0), b2, voffB);
            PG8_BAR; PG8_WAIT_L(0); PG8_MMA(0, 1, At, B1); PG8_BAR;
            PG8_LDA(At, 0, 1); PG8_STAGE(PG8_SA(0, 0), a2, voffA);
            PG8_BAR; PG8_WAIT_L(0); PG8_MMA(1, 0, At, B0); PG8_BAR; PG8_SCHED;
            PG8_STAGE(PG8_SB(0, 1), b2 + hstep, voffB);
            PG8_WAIT_V(6); PG8_BAR; PG8_MMA(1, 1, At, B1); PG8_BAR;
            PG8_LDB(B0, 1, 0); PG8_SCHED; PG8_LDA(At, 1, 0); PG8_STAGE(PG8_SA(0, 1), a2 + hstep, voffA);
            PG8_WAIT_L(8); PG8_BAR; PG8_WAIT_L(0); PG8_MMA(0, 0, At, B0); PG8_BAR; PG8_SCHED;
            PG8_LDB(B1, 1, 1); PG8_STAGE(PG8_SB(1, 0), b3, voffB);
            PG8_BAR; PG8_WAIT_L(0); PG8_MMA(0, 1, At, B1); PG8_BAR;
            PG8_LDA(At, 1, 1); PG8_STAGE(PG8_SA(1, 0), a3, voffA);
            PG8_BAR; PG8_WAIT_L(0); PG8_MMA(1, 0, At, B0); PG8_BAR; PG8_SCHED;
            PG8_STAGE(PG8_SB(1, 1), b3 + hstep, voffB);
            PG8_WAIT_V(6); PG8_BAR; PG8_MMA(1, 1, At, B1); PG8_BAR;
            }
        }
        if constexpr (ALIGN_EPI) { if (wr == 0) PG8_BAR; }
        if constexpr (!Epi::AFTER_DRAIN) { E(acc, cur, wr, wc, fr, fq); S.done(cur); }
        if (!has_next) break;
#pragma unroll
        for (int a = 0; a < 2; ++a)
#pragma unroll
            for (int b = 0; b < 2; ++b)
#pragma unroll
                for (int m = 0; m < 4; ++m)
#pragma unroll
                    for (int n = 0; n < 2; ++n) acc[a][b][m][n] = (f32x4){0.f, 0.f, 0.f, 0.f};
        cur = nxt; cA = nA; cB = nB; ++ui;
        if constexpr (ALIGN_EPI) { if (wr == 1) PG8_BAR; }
    }
    PG8_WAIT_V(0);
    if constexpr (!ALIGN_EPI) { if (wr == 0) PG8_BAR; }
    PG8_BAR;
    if constexpr (Epi::AFTER_DRAIN) { E.fused(acc, cur, wr, wc, fr, fq, lds, wid, lane); S.done(cur); }
#undef PG8_SA
#undef PG8_SB
#undef PG8_STAGE
#undef PG8_LDA
#undef PG8_LDB
#undef PG8_MMA
#undef PG8_WAIT_V
#undef PG8_WAIT_L
#undef PG8_BAR
#undef PG8_SCHED
}
}

#define LAS __attribute__((address_space(3)))
typedef unsigned short bf16_t;
typedef short bf16x8 __attribute__((ext_vector_type(8)));
typedef short s16x4 __attribute__((ext_vector_type(4)));
typedef float f32x4 __attribute__((ext_vector_type(4)));
typedef float f32x2 __attribute__((ext_vector_type(2)));
typedef float f32x16 __attribute__((ext_vector_type(16)));
typedef unsigned u32x4 __attribute__((ext_vector_type(4)));
typedef unsigned u32x2 __attribute__((ext_vector_type(2)));
using pg8::cvt_pk_bf16; using pg8::TOK_P; using pg8::TOK_ALL; using pg8::LOG2E;

constexpr int MP = 16640;
constexpr int LROWS = 33280;
constexpr int SEQS = 2112;
constexpr float EPS = 1e-6f;
constexpr size_t al256(size_t x) { return (x + 255) & ~(size_t)255; }
constexpr size_t WS_CTL = 0;
constexpr size_t CTL_BYTES = 131072;
constexpr int CW_RS = 16384;
constexpr size_t WS_ROPEDF = 1u << 20;
constexpr size_t WS_ROPEMLA = WS_ROPEDF + 4096 * 16 * 4;
constexpr size_t WS_W0 = 2u << 20;
constexpr size_t SZ_GU = (size_t)5632 * 1024 * 2, SZ_DN = (size_t)1024 * 2816 * 2, SZ_SQ = (size_t)1024 * 1024 * 2, SZ_PLEI = (size_t)1024 * 256 * 2;
constexpr size_t WS_GU = WS_W0;
constexpr size_t WS_DN = WS_GU + 4 * SZ_GU;
constexpr size_t WS_PLEG = WS_DN + 4 * SZ_DN;
constexpr size_t WS_PLEI = WS_PLEG + 2 * SZ_SQ;
constexpr size_t WS_ABIN = WS_PLEI + 2 * SZ_PLEI;
constexpr size_t WS_ABOUT = WS_ABIN + (size_t)3072 * 1024 * 2;
constexpr size_t WS_MLAIN = WS_ABOUT + SZ_SQ;
constexpr size_t WS_UQ = WS_MLAIN + (size_t)768 * 1024 * 2;
constexpr size_t WS_UKV = WS_UQ + (size_t)1536 * 384 * 2;
constexpr size_t WS_MLAOUT = WS_UKV + (size_t)2048 * 256 * 2;
constexpr size_t WS_A = al256(WS_MLAOUT + SZ_SQ);
constexpr size_t WS_PB = WS_A + (size_t)MP * 1024 * 2;
constexpr size_t WS_LAT = WS_PB + (size_t)2 * MP * 256 * 2;
constexpr size_t WS_KR = WS_LAT + (size_t)LROWS * 256 * 2;
constexpr size_t WS_CQ = WS_KR + (size_t)LROWS * 32 * 2;
constexpr size_t WS_BIG = al256(WS_CQ + (size_t)MP * 384 * 2);
constexpr size_t SZ_ACT = (size_t)MP * 2816 * 2, SZ_F = (size_t)MP * 1024 * 4, SZ_SKV1 = (size_t)8 * SEQS * 512 * 2, SZ_KVP1 = (size_t)16384 * 512 * 2;
constexpr size_t WS_ACT = WS_BIG;
constexpr size_t WS_F = WS_BIG + SZ_ACT;
constexpr size_t WS_SKV = WS_F + SZ_F;
constexpr size_t WS_PART = WS_SKV + 4 * SZ_SKV1;
constexpr size_t WS_PIN = WS_PART + (size_t)11 * 256 * 1024 * 4;
constexpr size_t WS_XB = WS_PIN + (size_t)256 * 1024 * 4;
constexpr size_t WS_END = WS_XB + (size_t)2 * 16384 * 4 * 4;
constexpr size_t WS_Q0 = WS_BIG;
constexpr size_t WS_KVP = WS_Q0 + (size_t)2 * MP * 512 * 2;
constexpr size_t WS_DFO = al256(WS_KVP + 4 * SZ_KVP1);
static_assert(WS_DFO + (size_t)2 * MP * 512 * 2 <= WS_SKV, "layer-0 overlay");
constexpr size_t WS_MI = WS_F;
constexpr size_t WS_Q96 = WS_BIG;
constexpr size_t WS_KN = WS_Q96 + (size_t)MP * 1536 * 2;
constexpr size_t WS_VV = WS_KN + (size_t)LROWS * 1024 * 2;
static_assert(WS_VV + (size_t)LROWS * 1024 * 2 <= WS_PART, "layer-1 overlay");
static_assert((size_t)MP * 768 * 4 <= SZ_F, "MI fits F");
constexpr long OUT_SBK_P = 16908288, OUT_LAT_P = 50462720, OUT_KR_P = 54657024, OUT_SBK_S = 55181312, OUT_LAT_S = 55443456, OUT_KR_S = 55476224, OUT_TOTAL = 55480320;

constexpr int LDS_BYTES = 135168;
constexpr int LDS_MISC = 131072;

struct Args { const float* in[28]; float* out; unsigned char* ws; };
__device__ const float INV_DF[8] = {1.0f, 0.193922743f, 0.0376060307f, 0.00729266461f, 0.00141421356f, 0.000274248188f, 5.3182961e-05f, 1.03133862e-05f};
__device__ const float INV_MLA[16] = {1.0f, 0.562341332f, 0.316227764f, 0.177827939f, 0.100000001f, 0.0562341325f, 0.0316227749f, 0.0177827943f, 0.00999999978f, 0.00562341325f, 0.00316227763f, 0.00177827943f, 0.00100000005f, 0.000562341302f, 0.000316227757f, 0.00017782794f};

__device__ __forceinline__ float wave_sum(float v) {
    v += shx<1>(v); v += shx<2>(v); v += shx<4>(v); v += shx<8>(v); v += shx<16>(v);
    return __builtin_bit_cast(float, __builtin_amdgcn_readlane(__builtin_bit_cast(int, v), 0)) + __builtin_bit_cast(float, __builtin_amdgcn_readlane(__builtin_bit_cast(int, v), 32));
}
__device__ __forceinline__ unsigned pk2(float lo, float hi) { return cvt_pk_bf16(lo, hi); }

template <int MAP> __device__ __forceinline__ int wsrc(int v, int N) {
    if (MAP == 1) { const int q8 = v >> 3, r8 = v & 7; return r8 < 4 ? 4 * q8 + r8 : 2816 + 4 * q8 + (r8 - 4); }
    return v < N ? v : -1;
}
template <int MAP> __device__ __forceinline__ void transpose_item(const float* W, int K, int N, int Nv, bf16_t* WT, LAS float* scr, int item, int lane) {
    const int nblk = Nv / 32, kb = item / nblk, nb = item % nblk, k0 = 64 * kb, n0 = 32 * nb;
    const int c4 = lane & 7, kr = lane >> 3;
    const int sc = wsrc<MAP>(n0 + 4 * c4, N);
    f32x4 v[8];
#pragma unroll
    for (int i = 0; i < 8; ++i) v[i] = sc >= 0 ? *(const f32x4*)(W + (size_t)(k0 + 8 * i + kr) * N + sc) : (f32x4){0.f, 0.f, 0.f, 0.f};
#pragma unroll
    for (int i = 0; i < 8; ++i) { LAS float* d = scr + (8 * i + kr) * 33 + 4 * c4; d[0] = v[i][0]; d[1] = v[i][1]; d[2] = v[i][2]; d[3] = v[i][3]; }
    asm volatile("s_waitcnt lgkmcnt(0)" ::: "memory");
    const int c = lane & 7;
#pragma unroll
    for (int j = 0; j < 4; ++j) { const int n = (lane >> 3) + 8 * j; const LAS float* s = scr + (8 * c) * 33 + n;
        u32x4 o; o.x = pk2(s[0 * 33], s[1 * 33]); o.y = pk2(s[2 * 33], s[3 * 33]); o.z = pk2(s[4 * 33], s[5 * 33]); o.w = pk2(s[6 * 33], s[7 * 33]);
        *(u32x4*)(WT + (size_t)(n0 + n) * K + k0 + 8 * c) = o; }
    asm volatile("s_waitcnt lgkmcnt(0)" ::: "memory");
}
__device__ __forceinline__ void cvt_rows(const float* src, bf16_t* dst, int nrows, int width, int spr, int dpr, long gt, long ngt) {
    const int w4 = width >> 2; const long total = (long)nrows * w4;
    constexpr int U = 16;
    for (long q0 = gt; q0 < total; q0 += ngt * U) {
        f32x4 v[U];
#pragma unroll
        for (int u = 0; u < U; ++u) { const long q = q0 + ngt * u; if (q < total) { const int r = (int)(q / w4), c4 = (int)(q % w4); v[u] = __builtin_nontemporal_load((const f32x4*)(src + (size_t)r * width + 4 * c4)); } }
#pragma unroll
        for (int u = 0; u < U; ++u) { const long q = q0 + ngt * u; if (q < total) { const int r = (int)(q / w4), c4 = (int)(q % w4);
            const size_t dr = (size_t)(r / spr) * dpr + (r % spr);
            u32x2 w; w.x = pk2(v[u][0], v[u][1]); w.y = pk2(v[u][2], v[u][3]); *(u32x2*)(dst + dr * width + 4 * c4) = w; } }
    }
}
__device__ __forceinline__ void zero_segs(bf16_t* base, int nseq, size_t stride, int nel, long gt, long ngt) {
    const int n8 = nel >> 3; const long total = (long)nseq * n8;
    for (long q = gt; q < total; q += ngt) { const int s = (int)(q / n8), c = (int)(q % n8); *(u32x4*)(base + (size_t)s * stride + 8 * c) = (u32x4){0u, 0u, 0u, 0u}; }
}
__device__ __forceinline__ void sincos_tab(float ang, float& c, float& s) {
    double rev = (double)ang * 0.15915494309189535; rev -= floor(rev);
    const float rf = (float)rev; c = __builtin_amdgcn_cosf(rf); s = __builtin_amdgcn_sinf(rf);
}

template <bool FIRST, bool HASF, bool HASB, int KSUM = 0, bool GATE = false>
__device__ __forceinline__ void row_phase(const float* xp, const float* xs, float* X, const float* F, const float* ga, float coef, const float* gb, bf16_t* A, const float* part = nullptr, const float* pin = nullptr, int row_first = 0) {
    int t_ = threadIdx.x; asm volatile("" : "+v"(t_));
    const int lane = t_ & 63, gw = blockIdx.x * 8 + __builtin_amdgcn_readfirstlane(t_ >> 6), ngw = gridDim.x * 8;
    for (int row = row_first + gw; row < TOK_ALL; row += ngw) {
        const float* xr = FIRST ? (row < TOK_P ? xp + (size_t)row * 1024 : xs + (size_t)(row - TOK_P) * 1024) : X + (size_t)row * 1024;
        f32x4 x[4];
#pragma unroll
        for (int j = 0; j < 4; ++j) x[j] = ((const f32x4*)xr)[lane + 64 * j];
        if (HASF) {
            f32x4 f[4]; float ss = 0.f;
#pragma unroll
            for (int j = 0; j < 4; ++j) {
                if (KSUM > 0 && row >= TOK_P) {
                    f32x4 s = ((const f32x4*)(part + (size_t)(row - TOK_P) * 1024))[lane + 64 * j];
#pragma unroll
                    for (int k = 1; k < KSUM; ++k) s = s + ((const f32x4*)(part + ((size_t)k * 256 + (row - TOK_P)) * 1024))[lane + 64 * j];
                    if (GATE) { const f32x4 p = ((const f32x4*)(pin + (size_t)(row - TOK_P) * 1024))[lane + 64 * j];
#pragma unroll
                        for (int q = 0; q < 4; ++q) s[q] = p[q] * __builtin_amdgcn_rcpf(1.0f + __builtin_amdgcn_exp2f(-s[q] * LOG2E)); }
                    f[j] = s;
                } else f[j] = ((const f32x4*)(F + (size_t)row * 1024))[lane + 64 * j];
                ss += (f[j][0] * f[j][0] + f[j][1] * f[j][1]) + (f[j][2] * f[j][2] + f[j][3] * f[j][3]); }
            const float r = coef / sqrtf(wave_sum(ss) * (1.f / 1024.f) + EPS);
#pragma unroll
            for (int j = 0; j < 4; ++j) { const f32x4 g = ((const f32x4*)ga)[lane + 64 * j]; x[j] = x[j] + f[j] * g * r; ((f32x4*)(X + (size_t)row * 1024))[lane + 64 * j] = x[j]; }
        }
        if (HASB) {
            float ss = 0.f;
#pragma unroll
            for (int j = 0; j < 4; ++j) ss += (x[j][0] * x[j][0] + x[j][1] * x[j][1]) + (x[j][2] * x[j][2] + x[j][3] * x[j][3]);
            const float r = 1.0f / sqrtf(wave_sum(ss) * (1.f / 1024.f) + EPS);
#pragma unroll
            for (int j = 0; j < 4; ++j) { const f32x4 g = ((const f32x4*)gb)[lane + 64 * j]; const f32x4 y = x[j] * g * r;
                u32x2 w; w.x = pk2(y[0], y[1]); w.y = pk2(y[2], y[3]); ((u32x2*)(A + (size_t)row * 1024))[lane + 64 * j] = w; }
        }
    }
}
__device__ __forceinline__ void mla_row_phase(const float* MI, const float* qn, const float* kvn, const float* rope, bf16_t* CQ, bf16_t* LAT, bf16_t* KR, float* out) {
    int t_ = threadIdx.x; asm volatile("" : "+v"(t_));
    const int lane = t_ & 63, gw = blockIdx.x * 8 + __builtin_amdgcn_readfirstlane(t_ >> 6), ngw = gridDim.x * 8;
    for (int row = gw; row < TOK_ALL; row += ngw) {
        const float* mi = MI + (size_t)row * 768;
        const int lrow = row < TOK_P ? row : TOK_P + ((row - TOK_P) >> 4) * SEQS + 2048 + ((row - TOK_P) & 15);
        {   const f32x4 a = ((const f32x4*)mi)[lane]; const f32x2 b = ((const f32x2*)(mi + 256))[lane];
            const float ss = wave_sum((a[0] * a[0] + a[1] * a[1]) + (a[2] * a[2] + a[3] * a[3]) + (b[0] * b[0] + b[1] * b[1]));
            const float r = 1.0f / sqrtf(ss * (1.f / 384.f) + EPS);
            const f32x4 g = ((const f32x4*)qn)[lane]; const f32x2 g2 = ((const f32x2*)(qn + 256))[lane];
            u32x2 w; w.x = pk2(a[0] * r * g[0], a[1] * r * g[1]); w.y = pk2(a[2] * r * g[2], a[3] * r * g[3]);
            ((u32x2*)(CQ + (size_t)row * 384))[lane] = w; ((unsigned*)(CQ + (size_t)row * 384 + 256))[lane] = pk2(b[0] * r * g2[0], b[1] * r * g2[1]); }
        {   const f32x4 a = ((const f32x4*)(mi + 384))[lane];
            const float ss = wave_sum((a[0] * a[0] + a[1] * a[1]) + (a[2] * a[2] + a[3] * a[3]));
            const float r = 1.0f / sqrtf(ss * (1.f / 256.f) + EPS);
            const f32x4 g = ((const f32x4*)kvn)[lane]; const f32x4 y = a * g * r;
            float* op = row < TOK_P ? out + OUT_LAT_P + (size_t)row * 256 : out + OUT_LAT_S + (size_t)(row - TOK_P) * 256;
            __builtin_nontemporal_store(y, (f32x4*)op + lane);
            u32x2 w; w.x = pk2(y[0], y[1]); w.y = pk2(y[2], y[3]); ((u32x2*)(LAT + (size_t)lrow * 256))[lane] = w; }
        {   const int i = lane & 31; const float v = mi[640 + i]; const float oth = shx<16>(v);
            const int pos = pg8::tok_pos(row); const float c = rope[pos * 32 + (i & 15)], s = rope[pos * 32 + 16 + (i & 15)];
            const float y = (i < 16) ? v * c - oth * s : v * c + oth * s;
            const float yn = shx<1>(y);
            if (lane < 32) { float* op = row < TOK_P ? out + OUT_KR_P + (size_t)row * 32 : out + OUT_KR_S + (size_t)(row - TOK_P) * 32; op[i] = y;
                if ((lane & 1) == 0) ((unsigned*)(KR + (size_t)lrow * 32))[lane >> 1] = pk2(y, yn); } }
    }
}

__device__ __forceinline__ int crow(int r, int hi) { return (r & 3) + 8 * (r >> 2) + 4 * hi; }
__device__ __forceinline__ bf16x8 pack8(const f32x16& p, int b) {
    u32x4 w; w.x = pk2(p[b], p[b + 1]); w.y = pk2(p[b + 2], p[b + 3]); w.z = pk2(p[b + 4], p[b + 5]); w.w = pk2(p[b + 6], p[b + 7]); return __builtin_bit_cast(bf16x8, w);
}
__device__ __forceinline__ s16x4 vtr(const LAS unsigned char* p) { return __builtin_bit_cast(s16x4, __builtin_amdgcn_ds_read_tr16_b64_v4i16((LAS s16x4*)p)); }

template <int DQK, int DV, int MODE, int NCOMP>
__device__ __forceinline__ void attn_unit(LAS unsigned char* lds, const bf16_t* Qp, int ldq, const bf16_t* Kp, int ldk, const bf16_t* K2p, const bf16_t* Vp, int ldv,
                                          bf16_t* Op, int ldo, int nq, int qpos0, int ntiles, int kvalid, float lam, const float* subln) {
    constexpr int RSK = DQK * 2 + 16, RSV = DV * 2 + 64, KOFF = 0, VOFF = 16384, BUFB = 36864  , NS = DQK / 16, ND = DV / 32;
    constexpr int KC = DQK / 8, VC = DV / 8;
    constexpr int NKP = (64 * KC + 511) / 512, NVP = (64 * VC) / 512;
    int tid = threadIdx.x; asm volatile("" : "+v"(tid));
    const int lane = tid & 63, wid = __builtin_amdgcn_readfirstlane(tid >> 6), r32 = lane & 31, hi = lane >> 5;
    const int wq0 = 32 * wid; const bool wactive = wq0 < nq;
    const int qrow = (wq0 + r32 < nq) ? wq0 + r32 : nq - 1;
    const int qpos = qpos0 + wq0 + r32;
    const int cw = wactive ? ((qpos0 + wq0) >> 6) : -1;
    f32x16 osave[ND];
#pragma unroll
    for (int comp = 0; comp < NCOMP; ++comp) {
        bf16x8 qf[NS];
#pragma unroll
        for (int s = 0; s < NS; ++s) qf[s] = *(const bf16x8*)(Qp + (size_t)qrow * ldq + comp * 64 + 16 * s + 8 * hi);
        if (DQK == 96) {
            const float* rp = subln + (size_t)(qpos0 + qrow) * 32 + 8 * hi;
            u32x4 wa, wb;
#pragma unroll
            for (int j2 = 0; j2 < 4; ++j2) { float ra[2], rb[2];
#pragma unroll
                for (int jj = 0; jj < 2; ++jj) { const int j = 2 * j2 + jj;
                    const float x1 = __builtin_bit_cast(float, (unsigned)(unsigned short)qf[NS - 2][j] << 16), x2 = __builtin_bit_cast(float, (unsigned)(unsigned short)qf[NS - 1][j] << 16);
                    const float c = rp[j], s = rp[16 + j]; ra[jj] = x1 * c - x2 * s; rb[jj] = x2 * c + x1 * s; }
                wa[j2] = pk2(ra[0], ra[1]); wb[j2] = pk2(rb[0], rb[1]); }
            qf[NS - 2] = __builtin_bit_cast(bf16x8, wa); qf[NS - 1] = __builtin_bit_cast(bf16x8, wb);
        }
        f32x16 o[ND];
#pragma unroll
        for (int d = 0; d < ND; ++d)
#pragma unroll
            for (int r = 0; r < 16; ++r) o[d][r] = 0.f;
        float m_run = -INFINITY, l_run = 0.f, c_run = 0.f;
        u32x4 kreg[NKP], vreg[NVP];
#define ATT_ISSUE(tile_) do { const int tl_ = (tile_); \
            _Pragma("unroll") for (int i = 0; i < NKP; ++i) { const int pi = tid + 512 * i; if (pi < 64 * KC) { const int key = pi / KC, c = pi % KC; const size_t krow = (size_t)tl_ * 64 + key; \
                    const bf16_t* src = (DQK == 96 && c >= 8) ? K2p + krow * 32 + (c - 8) * 8 : Kp + krow * ldk + comp * 64 + c * 8; \
                    kreg[i] = *(const u32x4*)src; } } \
            _Pragma("unroll") for (int i = 0; i < NVP; ++i) { const int pi = tid + 512 * i; const int key = pi / VC, c = pi % VC; vreg[i] = *(const u32x4*)(Vp + ((size_t)tl_ * 64 + key) * ldv + c * 8); } \
        } while (0)
#define ATT_WRITE(boff_) do { \
            _Pragma("unroll") for (int i = 0; i < NKP; ++i) { const int pi = tid + 512 * i; if (pi < 64 * KC) { const int key = pi / KC, c = pi % KC; *(LAS u32x4*)(lds + (boff_) + KOFF + key * RSK + c * 16) = kreg[i]; } } \
            _Pragma("unroll") for (int i = 0; i < NVP; ++i) { const int pi = tid + 512 * i; const int key = pi / VC, c = pi % VC; *(LAS u32x4*)(lds + (boff_) + VOFF + key * RSV + c * 16) = vreg[i]; } \
        } while (0)
        volatile LAS int* dflag = (volatile LAS int*)(lds + LDS_MISC + 128);
        bool wdone = !wactive;
        ATT_ISSUE(MODE == 1 ? ntiles - 1 : 0);
        ATT_WRITE(0);
        if (ntiles > 1) ATT_ISSUE(MODE == 1 ? ntiles - 2 : 1);
        __syncthreads();
        for (int it = 0; it < ntiles; ++it) {
            const int tile = MODE == 1 ? ntiles - 1 - it : it;
            const int boff = (it & 1) * BUFB;
            if (it + 1 < ntiles) { ATT_WRITE(BUFB - boff); if (it + 2 < ntiles) ATT_ISSUE(MODE == 1 ? tile - 2 : tile + 2); }
            if (tile <= cw) {
                f32x16 p0, p1;
#pragma unroll
                for (int r = 0; r < 16; ++r) { p0[r] = 0.f; p1[r] = 0.f; }
                const LAS unsigned char* kb = lds + boff + KOFF + r32 * RSK + hi * 16;
#pragma unroll
                for (int s = 0; s < NS; ++s) {
                    const bf16x8 a0 = *(const LAS bf16x8*)(kb + s * 32), a1 = *(const LAS bf16x8*)(kb + 32 * RSK + s * 32);
                    p0 = __builtin_amdgcn_mfma_f32_32x32x16_bf16(a0, qf[s], p0, 0, 0, 0);
                    p1 = __builtin_amdgcn_mfma_f32_32x32x16_bf16(a1, qf[s], p1, 0, 0, 0);
                }
                if (MODE == 0) {
                    if (__builtin_expect(tile * 64 + 64 > kvalid, 0)) {
                        asm volatile("" ::: "memory");
#pragma unroll
                        for (int r = 0; r < 16; ++r) { const int kp = tile * 64 + crow(r, hi); if (kp >= kvalid) p0[r] = -INFINITY; if (kp + 32 >= kvalid) p1[r] = -INFINITY; }
                        asm volatile("" : "+v"(p0), "+v"(p1));
                    }
                    float mx = __builtin_fmaxf(__builtin_fmaxf(p0[0], p1[0]), p0[1]);
#pragma unroll
                    for (int r = 1; r < 15; ++r) mx = __builtin_fmaxf(__builtin_fmaxf(mx, p1[r]), p0[r + 1]);
                    mx = __builtin_fmaxf(mx, p1[15]);
                    mx = max32(mx, lane);
                    const float mn = fmaxf(m_run, mx), alpha = __builtin_amdgcn_exp2f(m_run - mn); m_run = mn;
                    {   const f32x2 mn2 = {mn, mn};
#pragma unroll
                        for (int r = 0; r < 16; r += 2) { f32x2 t0 = {p0[r], p0[r + 1]}, t1 = {p1[r], p1[r + 1]}; t0 = t0 - mn2; t1 = t1 - mn2;
                            asm volatile("" : "+v"(t0), "+v"(t1));
                            p0[r] = __builtin_amdgcn_exp2f(t0[0]); p0[r + 1] = __builtin_amdgcn_exp2f(t0[1]); p1[r] = __builtin_amdgcn_exp2f(t1[0]); p1[r + 1] = __builtin_amdgcn_exp2f(t1[1]); } }
                    const f32x16 ps = p0 + p1;
                    const float ls = ((ps[0] + ps[1]) + (ps[2] + ps[3])) + ((ps[4] + ps[5]) + (ps[6] + ps[7])) + (((ps[8] + ps[9]) + (ps[10] + ps[11])) + ((ps[12] + ps[13]) + (ps[14] + ps[15])));
                    l_run = l_run * alpha + ls;
#pragma unroll
                    for (int d = 0; d < ND; ++d) o[d] = o[d] * alpha;
                } else {
                    f32x16 lf0, lf1; float gs[2][4];
#pragma unroll
                    for (int r = 0; r < 16; ++r) {
                        const int kp = tile * 64 + crow(r, hi);
                        const float z0 = p0[r], z1 = p1[r];
                        const float s0 = fmaxf(z0, 0.f) + __builtin_amdgcn_logf(1.0f + __builtin_amdgcn_exp2f(-fabsf(z0)));
                        const float s1 = fmaxf(z1, 0.f) + __builtin_amdgcn_logf(1.0f + __builtin_amdgcn_exp2f(-fabsf(z1)));
                        lf0[r] = (kp < qpos) ? -s0 : 0.f; lf1[r] = (kp + 32 < qpos) ? -s1 : 0.f;
                    }
#pragma unroll
                    for (int g = 0; g < 4; ++g) { gs[0][g] = (lf0[4 * g] + lf0[4 * g + 1]) + (lf0[4 * g + 2] + lf0[4 * g + 3]); gs[1][g] = (lf1[4 * g] + lf1[4 * g + 1]) + (lf1[4 * g + 2] + lf1[4 * g + 3]); }
                    float running = c_run;
#pragma unroll
                    for (int kh = 1; kh >= 0; --kh)
#pragma unroll
                        for (int g = 3; g >= 0; --g) {
                            const float pg = shx32(gs[kh][g], lane);
                            float b = running + (hi ? 0.f : pg);
#pragma unroll
                            for (int e = 3; e >= 0; --e) {
                                const int r = 4 * g + e; const int kp = tile * 64 + 32 * kh + crow(r, hi);
                                const float z = kh ? p1[r] : p0[r], lfv = kh ? lf1[r] : lf0[r];
                                const float w = (kp < qpos) ? __builtin_amdgcn_exp2f(z + lfv + b) : 0.f;
                                b += lfv;
                                if (kh) p1[r] = w; else p0[r] = w;
                            }
                            running += gs[kh][g] + pg;
                        }
                    c_run = running;
                    wdone = (__builtin_amdgcn_ballot_w64(c_run > -160.f) == 0ull);
                }
                const bf16x8 pb0 = pack8(p0, 0), pb1 = pack8(p0, 8), pb2 = pack8(p1, 0), pb3 = pack8(p1, 8);
                const LAS unsigned char* vb = lds + boff + VOFF + (4 * hi + ((lane & 15) >> 2)) * RSV + ((lane >> 4) & 1) * 32 + (lane & 3) * 8;
#pragma unroll
                for (int d = 0; d < ND; ++d) {
#pragma unroll
                    for (int ks = 0; ks < 4; ++ks) {
                        const s16x4 lo = vtr(vb + (16 * ks) * RSV + d * 64), hh = vtr(vb + (16 * ks + 8) * RSV + d * 64);
                        const bf16x8 vf = (bf16x8){lo[0], lo[1], lo[2], lo[3], hh[0], hh[1], hh[2], hh[3]};
                        const bf16x8 pb = ks == 0 ? pb0 : ks == 1 ? pb1 : ks == 2 ? pb2 : pb3;
                        o[d] = __builtin_amdgcn_mfma_f32_32x32x16_bf16(vf, pb, o[d], 0, 0, 0);
                    }
                }
            }
            if (MODE == 1 && lane == 0) dflag[(it & 1) * 8 + wid] = wdone ? 1 : 0;
            __syncthreads();
            if (MODE == 1) { int all = 1;
#pragma unroll
                for (int w = 0; w < 8; ++w) all &= dflag[(it & 1) * 8 + w];
                if (all) break; }
        }
        if (MODE == 0) {
            const float lt = sum32(l_run, lane); const float inv = 1.0f / lt;
#pragma unroll
            for (int d = 0; d < ND; ++d)
#pragma unroll
                for (int r = 0; r < 16; ++r) o[d][r] *= inv;
        }
        if (NCOMP == 2 && comp == 0) {
#pragma unroll
            for (int d = 0; d < ND; ++d) osave[d] = o[d];
        } else {
            if (NCOMP == 2) {
                float ss = 0.f;
#pragma unroll
                for (int d = 0; d < ND; ++d)
#pragma unroll
                    for (int r = 0; r < 16; ++r) { o[d][r] = osave[d][r] - lam * o[d][r]; ss += o[d][r] * o[d][r]; }
                ss = sum32(ss, lane);
                const float rn = 0.8f / sqrtf(ss * (1.f / DV) + EPS);
#pragma unroll
                for (int d = 0; d < ND; ++d)
#pragma unroll
                    for (int g = 0; g < 4; ++g) { const f32x4 sg = *(const f32x4*)(subln + 32 * d + 8 * g + 4 * hi);
#pragma unroll
                        for (int e = 0; e < 4; ++e) o[d][4 * g + e] *= rn * sg[e]; }
            }
            if (wq0 + r32 < nq) {
                bf16_t* orow = Op + (size_t)(wq0 + r32) * ldo;
#pragma unroll
                for (int d = 0; d < ND; ++d)
#pragma unroll
                    for (int g = 0; g < 4; ++g) { u32x2 w; w.x = pk2(o[d][4 * g], o[d][4 * g + 1]); w.y = pk2(o[d][4 * g + 2], o[d][4 * g + 3]); *(u32x2*)(orow + 32 * d + 8 * g + 4 * hi) = w; }
            }
        }
    }
}

__device__ __forceinline__ int next_unit(unsigned* ctr, volatile LAS int* slot) {
    __syncthreads();
    if (threadIdx.x == 0) *slot = (int)atomicAdd(ctr, 1u);
    __syncthreads();
    return *slot;
}

template <class Epi> __device__ __forceinline__ void run_gemm(LAS unsigned char* lds, const bf16_t* A, const bf16_t* Bt, int M, int N, int K, const Epi& E) {
    pg8::Gemm g{A, Bt, M, N, K, K}; pg8::StaticOrder S; S.init(M, N, (int)gridDim.x, (int)blockIdx.x);
    pg8::gemm_phase<Epi, pg8::StaticOrder, true, true>(lds, g, S, E);
}
template <class Epi> __device__ __forceinline__ void run_gemm_fused(LAS unsigned char* lds, const bf16_t* A, const bf16_t* Bt, int K, const Epi& E) {
    pg8::Gemm g{A, Bt, TOK_P, 1024, K, K}; pg8::StaticOrder S; S.init(TOK_P, 1024, (int)gridDim.x, (int)blockIdx.x);
    pg8::gemm_phase<Epi, pg8::StaticOrder, false, true>(lds, g, S, E);
}
template <class Epi> __device__ __forceinline__ void run_gemm_split(LAS unsigned char* lds, const bf16_t* A, const bf16_t* Bt, int N, int K, int KS, const Epi& E) {
    pg8::Gemm g{A, Bt, 256, N, K / KS, K}; pg8::SplitOrder S; S.init(N, KS, TOK_P / 256, K / KS, (int)gridDim.x, (int)blockIdx.x);
    pg8::gemm_phase<Epi, pg8::SplitOrder, true, true>(lds, g, S, E);
}

#define OPQ() unsigned char* w_ = ws; asm volatile("" : "+s"(w_)); float* out_ = out; asm volatile("" : "+s"(out_))
#define ctl ((unsigned*)(w_ + WS_CTL))
#define ropedf ((float*)(w_ + WS_ROPEDF))
#define ropemla ((float*)(w_ + WS_ROPEMLA))
#define Abuf ((bf16_t*)(w_ + WS_A))
#define PB ((bf16_t*)(w_ + WS_PB))
#define LAT ((bf16_t*)(w_ + WS_LAT))
#define KR ((bf16_t*)(w_ + WS_KR))
#define CQ ((bf16_t*)(w_ + WS_CQ))
#define ACT ((bf16_t*)(w_ + WS_ACT))
#define F ((float*)(w_ + WS_F))
#define SKV ((bf16_t*)(w_ + WS_SKV))
#define Q0 ((bf16_t*)(w_ + WS_Q0))
#define KVP ((bf16_t*)(w_ + WS_KVP))
#define DFO ((bf16_t*)(w_ + WS_DFO))
#define MI ((float*)(w_ + WS_MI))
#define Q96 ((bf16_t*)(w_ + WS_Q96))
#define KN ((bf16_t*)(w_ + WS_KN))
#define VV ((bf16_t*)(w_ + WS_VV))
#define WSB(off) ((const bf16_t*)(w_ + (off)))
#define PART ((float*)(w_ + WS_PART))
#define PIN ((float*)(w_ + WS_PIN))
#define RSTAT(k_) pg8::RowStat{(unsigned*)(w_ + WS_XB + (size_t)(((k_) & 1) ^ 1) * 16384 * 16), (unsigned*)(w_ + WS_CTL) + CW_RS, 32u * (unsigned)(k_), 1.0f / 1024.0f, EPS}
#define XK(site_) ((l * 4 + (site_)) * 2 + 1)


constexpr int CW_BAR = 4096;
#define XB_TMO      128
#define XB_XCNT(j)  (256  + 64 * (j))
#define XB_XSUB(j)  (1280 + 64 * (j))
#define XB_XGEN(j)  (2304 + 64 * (j))
#define XB_TOP      3328
#define XB_TOPGEN   3392
#define XCD_BAR_WORDS 3456
#define XB_SPIN_CAP (1u << 18)

__device__ __forceinline__ unsigned xb_ld(unsigned* p)              { return __hip_atomic_load(p, __ATOMIC_RELAXED, __HIP_MEMORY_SCOPE_AGENT); }
__device__ __forceinline__ unsigned xb_add(unsigned* p, unsigned v) { return __hip_atomic_fetch_add(p, v, __ATOMIC_RELAXED, __HIP_MEMORY_SCOPE_AGENT); }
__device__ __forceinline__ unsigned xb_xcc_id() { return (unsigned)__builtin_amdgcn_s_getreg((3 << 11) | 20) & 0xFu; }
#define XB_SPIN(cond, bar) do { unsigned _sp = 0; while (cond) { __builtin_amdgcn_s_sleep(1); \
    if ((++_sp & 255u) == 0u) { if (xb_ld(&(bar)[XB_TMO])) break; if (_sp > XB_SPIN_CAP) { atomicAdd(&(bar)[XB_TMO], 1u); break; } } } } while (0)

struct XcdBarrier {
    unsigned* bar; unsigned x;
    volatile LAS unsigned* st;
};

__device__ __forceinline__ XcdBarrier xcd_barrier_post(unsigned* bar, volatile LAS unsigned* st) {
    XcdBarrier b; b.bar = bar; b.x = xb_xcc_id(); b.st = st;
    if (threadIdx.x == 0) (void)xb_add(&bar[XB_XCNT(b.x)], 1u);
    return b;
}
__device__ __forceinline__ void xcd_barrier_complete(unsigned* bar, unsigned x, unsigned& nloc, unsigned& nx) {
    const unsigned G = gridDim.x * gridDim.y * gridDim.z;
    unsigned sum, cnt, mine, sp = 0u;
    for (;;) {
        sum = 0u; cnt = 0u; mine = 0u;
#pragma unroll
        for (unsigned j = 0; j < 16; ++j) { const unsigned c = xb_ld(&bar[XB_XCNT(j)]); sum += c; cnt += (c > 0u) ? 1u : 0u; mine = (j == x) ? c : mine; }
        if (sum == G) break;
        __builtin_amdgcn_s_sleep(1);
        if ((++sp & 255u) == 0u) { if (xb_ld(&bar[XB_TMO])) break; if (sp > XB_SPIN_CAP) { atomicAdd(&bar[XB_TMO], 1u); break; } }
    }
    nloc = mine > 0u ? mine : 1u; nx = cnt > 0u ? cnt : 1u;
}

__device__ __forceinline__ void xcd_barrier(const XcdBarrier& b) {
    asm volatile("s_waitcnt vmcnt(0)" ::: "memory");
    __syncthreads();
    if (threadIdx.x == 0) {
        unsigned* bar = b.bar;
        __builtin_amdgcn_s_waitcnt(0);
        unsigned nloc = b.st[0], nx = b.st[1];
        if (nloc == 0u) { xcd_barrier_complete(bar, b.x, nloc, nx); b.st[0] = nloc; b.st[1] = nx; }
        const unsigned old = xb_add(&bar[XB_XSUB(b.x)], 1u);
        const unsigned gen = old / nloc;
        if (old + 1u == (gen + 1u) * nloc) {
            __builtin_amdgcn_fence(__ATOMIC_RELEASE, "agent");
            asm volatile("s_waitcnt vmcnt(0)" ::: "memory");
            const unsigned og = xb_add(&bar[XB_TOP], 1u);
            const unsigned tg = og / nx;
            if (og + 1u == (tg + 1u) * nx) xb_add(&bar[XB_TOPGEN], 1u);
            else XB_SPIN(xb_ld(&bar[XB_TOPGEN]) == tg, bar);
            __builtin_amdgcn_fence(__ATOMIC_ACQUIRE, "agent");
            xb_add(&bar[XB_XGEN(b.x)], 1u);
            asm volatile("s_waitcnt vmcnt(0)" ::: "memory");
        } else {
            XB_SPIN(xb_ld(&bar[XB_XGEN(b.x)]) == gen, bar);
            __builtin_amdgcn_fence(__ATOMIC_ACQUIRE, "agent");
            asm volatile("s_waitcnt vmcnt(0)" ::: "memory");
        }
    }
    __syncthreads();
}

template <int l> __device__ __forceinline__ void layer_body(const Args& a, LAS unsigned char* lds, unsigned char* ws, float* out, const float* norms, volatile LAS int* slot, const XcdBarrier& bar) {
        const float* g = norms + (size_t)l * 8 * 1024;
        { OPQ(); pg8::EpiSwiglu E{ACT, 2816}; run_gemm(lds, Abuf, WSB(WS_GU + (size_t)(l * 2 + 0) * SZ_GU), MP, 5632, 1024, E); }
        xcd_barrier(bar);
        { OPQ(); pg8::EpiRms2<false, true> E{l == 0 ? a.in[0] : (const float*)out_, out_, Abuf, nullptr, g + 1024, g + 2048, 0.5f, RSTAT(XK(0)), RSTAT(XK(0) + 1)};
          run_gemm_fused(lds, ACT, WSB(WS_DN + (size_t)(l * 2 + 0) * SZ_DN), 2816, E); }
        { OPQ(); pg8::EpiPart E{PART, 1024, 512}; run_gemm_split(lds, ACT, WSB(WS_DN + (size_t)(l * 2 + 0) * SZ_DN), 1024, 2816, 11, E); }
        xcd_barrier(bar);
        { OPQ(); if (l == 0) row_phase<true, true, true, 11>(a.in[0], a.in[1], out_, F, g + 1024, 0.5f, g + 2048, Abuf, PART, nullptr, TOK_P);
          else row_phase<false, true, true, 11>(nullptr, nullptr, out_, F, g + 1024, 0.5f, g + 2048, Abuf, PART, nullptr, TOK_P); }
        xcd_barrier(bar);
        if (l == 0) {
            { OPQ(); pg8::EpiAbIn E{out_, Q0, KVP, SKV, ropedf, OUT_SBK_P, OUT_SBK_S, 0.125f * LOG2E};
              run_gemm(lds, Abuf, WSB(WS_ABIN), MP, 3072, 1024, E); }
            xcd_barrier(bar);
            {   OPQ();
                const float* lv = a.in[19];
                int tl_ = threadIdx.x; asm volatile("" : "+v"(tl_)); const int lane = tl_ & 63;
                const float d01 = wave_sum(lv[lane] * lv[64 + lane]), d23 = wave_sum(lv[128 + lane] * lv[192 + lane]);
                const float lam = expf(d01) - expf(d23) + 0.2f;
                const size_t PSZ = (size_t)16384 * 512, SSZ = (size_t)8 * SEQS * 512;
                const int rep_ = 0;
                for (;;) {
                    const int u = next_unit(ctl + 0 + 128 * rep_, slot);
                    if (u >= 1152) break;
                    int type, qb = 0, idx;
                    if (u < 64) { type = 1; idx = u; }
                    else if (u < 576) { type = 0; qb = 15 - (u - 64) / 32; idx = (u - 64) % 32; }
                    else if (u < 1088) { type = 2; qb = 15 - (u - 576) / 32; idx = (u - 576) % 32; }
                    else { type = 3; idx = u - 1088; }
                    const bool smp = (type & 1) != 0;
                    if (type < 2) {
                        const int comp = idx & 1, bh = idx >> 1, b = bh >> 2, h = bh & 3;
                        const size_t row0 = smp ? (size_t)TOK_P + 16 * b : (size_t)b * 4096 + 256 * qb;
                        const bf16_t* Kb = smp ? SKV + 2 * SSZ + (size_t)b * SEQS * 512 : KVP + 2 * PSZ + (size_t)b * 4096 * 512;
                        const bf16_t* Vb = smp ? SKV + 3 * SSZ + (size_t)b * SEQS * 512 : KVP + 3 * PSZ + (size_t)b * 4096 * 512;
                        attn_unit<64, 128, 0, 1>(lds, Q0 + (size_t)MP * 512 + row0 * 512 + h * 128 + comp * 64, 512, Kb + h * 128 + comp * 64, 512, nullptr, Vb + h * 128, 512,
                                                 DFO + (size_t)comp * MP * 512 + row0 * 512 + h * 128, 512, smp ? 16 : 256, smp ? 2048 : 256 * qb, smp ? 33 : 4 * qb + 4, smp ? 2064 : (1 << 30), 0.f, nullptr);
                    } else {
                        const int b = idx >> 3, h = idx & 7;
                        const size_t row0 = smp ? (size_t)TOK_P + 16 * b : (size_t)b * 4096 + 256 * qb;
                        const bf16_t* Kb = smp ? SKV + (size_t)b * SEQS * 512 : KVP + (size_t)b * 4096 * 512;
                        const bf16_t* Vb = smp ? SKV + SSZ + (size_t)b * SEQS * 512 : KVP + PSZ + (size_t)b * 4096 * 512;
                        attn_unit<64, 64, 1, 1>(lds, Q0 + row0 * 512 + h * 64, 512, Kb + h * 64, 512, nullptr, Vb + h * 64, 512,
                                                Abuf + row0 * 1024 + h * 64, 1024, smp ? 16 : 256, smp ? 2048 : 256 * qb, smp ? 33 : 4 * qb + 4, 1 << 30, 0.f, nullptr);
                    }
                }
                (void)lam;
            }
            xcd_barrier(bar);
            {
                OPQ(); int t_ = threadIdx.x; asm volatile("" : "+v"(t_));
                const int lane = t_ & 63, gw = blockIdx.x * 8 + __builtin_amdgcn_readfirstlane(t_ >> 6), ngw = gridDim.x * 8;
                const float* lv = a.in[19];
                const float d01 = wave_sum(lv[lane] * lv[64 + lane]), d23 = wave_sum(lv[128 + lane] * lv[192 + lane]);
                const float lam = expf(d01) - expf(d23) + 0.2f;
                const f32x2 sg = ((const f32x2*)a.in[20])[lane];
                for (int it = gw; it < TOK_ALL * 4; it += ngw) { const int row = it >> 2, h = it & 3;
                    const unsigned w1 = ((const unsigned*)(DFO + (size_t)row * 512 + h * 128))[lane], w2 = ((const unsigned*)(DFO + (size_t)MP * 512 + (size_t)row * 512 + h * 128))[lane];
                    const float a0 = __builtin_bit_cast(float, w1 << 16) - lam * __builtin_bit_cast(float, w2 << 16), a1 = __builtin_bit_cast(float, w1 & 0xffff0000u) - lam * __builtin_bit_cast(float, w2 & 0xffff0000u);
                    const float rn = 0.8f / sqrtf(wave_sum(a0 * a0 + a1 * a1) * (1.f / 128.f) + EPS);
                    ((unsigned*)(Abuf + (size_t)row * 1024 + 512 + h * 128))[lane] = pk2(a0 * rn * sg[0], a1 * rn * sg[1]); }
            }
            xcd_barrier(bar);
            { OPQ(); pg8::EpiRms2<false, true> E{out_, out_, Abuf, nullptr, g + 3 * 1024, g + 4 * 1024, 1.0f, RSTAT(XK(1)), RSTAT(XK(1) + 1)}; run_gemm_fused(lds, Abuf, WSB(WS_ABOUT), 1024, E); }
            { OPQ(); pg8::EpiPart E{PART, 1024, 512}; run_gemm_split(lds, Abuf, WSB(WS_ABOUT), 1024, 1024, 4, E); }
        } else {
            { OPQ(); pg8::EpiF32 E{MI, 768}; run_gemm(lds, Abuf, WSB(WS_MLAIN), MP, 768, 1024, E); }
            xcd_barrier(bar);
            { OPQ(); mla_row_phase(MI, a.in[22], a.in[23], ropemla, CQ, LAT, KR, out_); }
            xcd_barrier(bar);
            { OPQ(); pg8::EpiBf16Split E{KN, VV, 1024, 1024, 1.0f}; run_gemm(lds, LAT, WSB(WS_UKV), LROWS, 2048, 256, E); }
            { OPQ(); pg8::EpiBf16Split E{Q96, Q96, 1536, 1 << 30, 0.10206207261596577f * LOG2E}; run_gemm(lds, CQ, WSB(WS_UQ), MP, 1536, 384, E); }
            xcd_barrier(bar);
            { OPQ();
            const int rep_ = 0;
            for (;;) {
                const int u = next_unit(ctl + 64 + 128 * rep_, slot);
                if (u >= 1152) break;
                bool smp = false; int qb = 0, idx;
                if (u < 128) { smp = true; idx = u; }
                else { qb = 15 - (u - 128) / 64; idx = (u - 128) % 64; }
                const int b = idx >> 4, h = idx & 15;
                const size_t row0 = smp ? (size_t)TOK_P + 16 * b : (size_t)b * 4096 + 256 * qb;
                const size_t krow0 = smp ? (size_t)TOK_P + (size_t)b * SEQS : (size_t)b * 4096;
                attn_unit<96, 64, 0, 1>(lds, Q96 + row0 * 1536 + h * 96, 1536, KN + krow0 * 1024 + h * 64, 1024, KR + krow0 * 32, VV + krow0 * 1024 + h * 64, 1024,
                                        Abuf + row0 * 1024 + h * 64, 1024, smp ? 16 : 256, smp ? 2048 : 256 * qb, smp ? 33 : 4 * qb + 4, smp ? 2064 : (1 << 30), 0.f, ropemla);
            } }
            xcd_barrier(bar);
            { OPQ(); pg8::EpiRms2<false, true> E{out_, out_, Abuf, nullptr, g + 3 * 1024, g + 4 * 1024, 1.0f, RSTAT(XK(1)), RSTAT(XK(1) + 1)}; run_gemm_fused(lds, Abuf, WSB(WS_MLAOUT), 1024, E); }
            { OPQ(); pg8::EpiPart E{PART, 1024, 512}; run_gemm_split(lds, Abuf, WSB(WS_MLAOUT), 1024, 1024, 4, E); }
        }
        xcd_barrier(bar);
        { OPQ(); row_phase<false, true, true, 4>(nullptr, nullptr, out_, F, g + 3 * 1024, 1.0f, g + 4 * 1024, Abuf, PART, nullptr, TOK_P); }
        xcd_barrier(bar);
        { OPQ(); pg8::EpiSwiglu E{ACT, 2816}; run_gemm(lds, Abuf, WSB(WS_GU + (size_t)(l * 2 + 1) * SZ_GU), MP, 5632, 1024, E); }
        xcd_barrier(bar);
        { OPQ(); pg8::EpiRms2<false, true> E{out_, out_, Abuf, nullptr, g + 5 * 1024, g + 6 * 1024, 0.5f, RSTAT(XK(2)), RSTAT(XK(2) + 1)};
          run_gemm_fused(lds, ACT, WSB(WS_DN + (size_t)(l * 2 + 1) * SZ_DN), 2816, E); }
        { OPQ(); pg8::EpiPart E{PART, 1024, 512}; run_gemm_split(lds, ACT, WSB(WS_DN + (size_t)(l * 2 + 1) * SZ_DN), 1024, 2816, 11, E); }
        xcd_barrier(bar);
        { OPQ(); row_phase<false, true, true, 11>(nullptr, nullptr, out_, F, g + 5 * 1024, 0.5f, g + 6 * 1024, Abuf, PART, nullptr, TOK_P); }
        xcd_barrier(bar);
        { OPQ(); pg8::EpiF32 E{F, 1024}; run_gemm(lds, PB + (size_t)l * MP * 256, WSB(WS_PLEI + (size_t)l * SZ_PLEI), TOK_P, 1024, 256, E); }
        { OPQ(); if (l == 0) { pg8::EpiRms2<true, true> E{out_, out_, Abuf, F, g + 7 * 1024, g + 8 * 1024, 1.0f, RSTAT(XK(3)), RSTAT(XK(3) + 1)}; run_gemm_fused(lds, Abuf, WSB(WS_PLEG + (size_t)l * SZ_SQ), 1024, E); }
          else { pg8::EpiRms2<true, false> E{out_, out_, nullptr, F, g + 7 * 1024, nullptr, 1.0f, RSTAT(XK(3)), RSTAT(XK(3) + 1)}; run_gemm_fused(lds, Abuf, WSB(WS_PLEG + (size_t)l * SZ_SQ), 1024, E); } }
        { OPQ(); pg8::EpiPart E{PIN, 1024, 512}; run_gemm_split(lds, PB + (size_t)l * MP * 256, WSB(WS_PLEI + (size_t)l * SZ_PLEI), 1024, 256, 1, E); }
        { OPQ(); pg8::EpiPart E{PART, 1024, 512}; run_gemm_split(lds, Abuf, WSB(WS_PLEG + (size_t)l * SZ_SQ), 1024, 1024, 4, E); }
        xcd_barrier(bar);
        { OPQ(); if (l == 0) row_phase<false, true, true, 4, true>(nullptr, nullptr, out_, F, g + 7 * 1024, 1.0f, g + 8 * 1024, Abuf, PART, PIN, TOK_P);
          else row_phase<false, true, false, 4, true>(nullptr, nullptr, out_, F, g + 7 * 1024, 1.0f, nullptr, nullptr, PART, PIN, TOK_P); }
        if (l == 0) xcd_barrier(bar);
}

__global__ void __launch_bounds__(512) fwd_megakernel(Args a) {
    extern __shared__ __attribute__((aligned(16))) unsigned char lds_raw[];
    LAS unsigned char* lds = (LAS unsigned char*)lds_raw;
    cg::grid_group grid = cg::this_grid();
    unsigned char* ws = a.ws; float* out = a.out;
    const float* norms = a.in[10];
    volatile LAS int* slot = (volatile LAS int*)(lds + LDS_MISC);
    volatile LAS unsigned* bst = (volatile LAS unsigned*)(lds + LDS_MISC + 64);
    if (threadIdx.x < 2) bst[threadIdx.x] = 0u;
    __syncthreads();
    const XcdBarrier bar = xcd_barrier_post((unsigned*)(ws + WS_CTL) + CW_BAR, bst);

    {
        OPQ();
        int tid = threadIdx.x; asm volatile("" : "+v"(tid));
        const int lane = tid & 63, wave = __builtin_amdgcn_readfirstlane(tid >> 6);
        const int G = gridDim.x, gw = blockIdx.x * 8 + wave, ngw = G * 8;
        const long gt = (long)blockIdx.x * 512 + tid, ngt = (long)G * 512;
        LAS float* scr = (LAS float*)(lds + wave * 16384);
        int base = 0;
#define TR(MAP, src, dst, K_, N_, Nv_) do { const int items_ = ((K_) / 64) * ((Nv_) / 32); \
            for (int it_ = (gw + ngw - (base % ngw)) % ngw; it_ < items_; it_ += ngw) transpose_item<MAP>((src), (K_), (N_), (Nv_), (bf16_t*)(dst), scr, it_, lane); base += items_; } while (0)
        for (int l = 0; l < 2; ++l) {
            TR(1, a.in[11] + (size_t)l * 1024 * 5632, w_ + WS_GU + (size_t)(l * 2 + 0) * SZ_GU, 1024, 5632, 5632);
            TR(1, a.in[13] + (size_t)l * 1024 * 5632, w_ + WS_GU + (size_t)(l * 2 + 1) * SZ_GU, 1024, 5632, 5632);
            TR(0, a.in[12] + (size_t)l * 2816 * 1024, w_ + WS_DN + (size_t)(l * 2 + 0) * SZ_DN, 2816, 1024, 1024);
            TR(0, a.in[14] + (size_t)l * 2816 * 1024, w_ + WS_DN + (size_t)(l * 2 + 1) * SZ_DN, 2816, 1024, 1024);
            TR(0, a.in[16] + (size_t)l * 1024 * 1024, w_ + WS_PLEG + (size_t)l * SZ_SQ, 1024, 1024, 1024);
            TR(0, a.in[15] + (size_t)l * 256 * 1024, w_ + WS_PLEI + (size_t)l * SZ_PLEI, 256, 1024, 1024);
        }
        TR(0, a.in[17], w_ + WS_ABIN, 1024, 3072, 3072);
        TR(0, a.in[18], w_ + WS_ABOUT, 1024, 1024, 1024);
        TR(0, a.in[21], w_ + WS_MLAIN, 1024, 672, 768);
        TR(0, a.in[24], w_ + WS_UQ, 384, 1536, 1536);
        TR(0, a.in[25], w_ + WS_UKV, 256, 1024, 1024);
        TR(0, a.in[26], w_ + WS_UKV + (size_t)1024 * 256 * 2, 256, 1024, 1024);
        TR(0, a.in[27], w_ + WS_MLAOUT, 1024, 1024, 1024);
#undef TR
        cvt_rows(a.in[4], SKV + (size_t)0 * (8 * SEQS * 512), 16384, 512, 2048, SEQS, gt, ngt);
        cvt_rows(a.in[5], SKV + (size_t)1 * (8 * SEQS * 512), 16384, 512, 2048, SEQS, gt, ngt);
        cvt_rows(a.in[6], SKV + (size_t)2 * (8 * SEQS * 512), 16384, 512, 2048, SEQS, gt, ngt);
        cvt_rows(a.in[7], SKV + (size_t)3 * (8 * SEQS * 512), 16384, 512, 2048, SEQS, gt, ngt);
        cvt_rows(a.in[8], LAT + (size_t)TOK_P * 256, 16384, 256, 2048, SEQS, gt, ngt);
        cvt_rows(a.in[9], KR + (size_t)TOK_P * 32, 16384, 32, 2048, SEQS, gt, ngt);
        for (int l = 0; l < 2; ++l) {
            cvt_rows(a.in[2] + (size_t)l * 16384 * 256, PB + (size_t)l * MP * 256, 16384, 256, 1 << 30, 0, gt, ngt);
            cvt_rows(a.in[3] + (size_t)l * 128 * 256, PB + (size_t)l * MP * 256 + (size_t)TOK_P * 256, 128, 256, 1 << 30, 0, gt, ngt);
            zero_segs(PB + (size_t)l * MP * 256 + (size_t)TOK_ALL * 256, 1, 0, 128 * 256, gt, ngt);
        }
        for (int i = 0; i < 4; ++i) zero_segs(SKV + (size_t)i * (8 * SEQS * 512) + (size_t)2064 * 512, 8, (size_t)SEQS * 512, 48 * 512, gt, ngt);
        zero_segs(LAT + ((size_t)TOK_P + 2064) * 256, 8, (size_t)SEQS * 256, 48 * 256, gt, ngt);
        zero_segs(KR + ((size_t)TOK_P + 2064) * 32, 8, (size_t)SEQS * 32, 48 * 32, gt, ngt);
        zero_segs(Abuf + (size_t)TOK_ALL * 1024, 1, 0, 128 * 1024, gt, ngt);
        zero_segs(CQ + (size_t)TOK_ALL * 384, 1, 0, 128 * 384, gt, ngt);
        for (long i = gt; i < 4096 * 8; i += ngt) { const int pos = (int)(i >> 3), k = (int)(i & 7); float c, s; sincos_tab((float)pos * INV_DF[k], c, s); ropedf[pos * 16 + k] = c; ropedf[pos * 16 + 8 + k] = s; }
        for (long i = gt; i < 4096 * 16; i += ngt) { const int pos = (int)(i >> 4), k = (int)(i & 15); float c, s; sincos_tab((float)pos * INV_MLA[k], c, s); ropemla[pos * 32 + k] = c; ropemla[pos * 32 + 16 + k] = s; }
        row_phase<true, false, true>(a.in[0], a.in[1], nullptr, nullptr, nullptr, 0.f, norms, Abuf);
    }
    grid.sync();

    layer_body<0>(a, lds, ws, out, norms, slot, bar);
    layer_body<1>(a, lds, ws, out, norms, slot, bar);
}

extern "C" void kernel_launch(void* const* d_in, const int* in_sizes, int n_in, void* d_out, int out_size, void* d_ws, size_t ws_size, hipStream_t stream) {
    static int grid = 0;
    if (grid == 0) {
        if (n_in != 28 || out_size != (int)OUT_TOTAL || ws_size < WS_END) { fprintf(stderr, "kernel_launch: unexpected shapes (n_in %d out %d ws %zu need %zu)\n", n_in, out_size, ws_size, (size_t)WS_END); grid = -1; return; }
        int dev = 0, cus = 0, per_cu = 0;
        hipGetDevice(&dev); hipDeviceGetAttribute(&cus, hipDeviceAttributeMultiprocessorCount, dev);
        hipFuncSetAttribute((const void*)fwd_megakernel, hipFuncAttributeMaxDynamicSharedMemorySize, LDS_BYTES);
        hipOccupancyMaxActiveBlocksPerMultiprocessor(&per_cu, (const void*)fwd_megakernel, 512, LDS_BYTES);
        if (per_cu < 1) { fprintf(stderr, "kernel_launch: occupancy query says %d blocks per CU\n", per_cu); per_cu = 1; }
        grid = 256;
        if (cus < 256) { fprintf(stderr, "kernel_launch: needs a 256-CU device (got %d)\n", cus); grid = -1; return; }
        (void)hipGetLastError();
    }
    if (grid < 0) return;
    hipMemsetAsync((char*)d_ws + WS_CTL, 0, CTL_BYTES, stream);
    Args a{};
    for (int i = 0; i < 28; ++i) a.in[i] = (const float*)d_in[i];
    a.out = (float*)d_out; a.ws = (unsigned char*)d_ws;
    void* args[] = {&a};
    hipError_t e = hipLaunchCooperativeKernel((const void*)fwd_megakernel, dim3(grid), dim3(512), args, LDS_BYTES, stream);
    if (e != hipSuccess) fprintf(stderr, "cooperative launch failed: %s (grid %d)\n", hipGetErrorString(e), grid);
}
```

```cpp
#include <hip/hip_runtime.h>
#include <hip/hip_cooperative_groups.h>
#include <cstdio>
#include <cstdint>
#include <cmath>
namespace cg = cooperative_groups;

template <int MASK> __device__ __forceinline__ float shx(float v) {
    static_assert(MASK > 0 && MASK < 32, "shx: xor mask 1..31");
    return __builtin_bit_cast(float, __builtin_amdgcn_ds_swizzle(__builtin_bit_cast(int, v), (MASK << 10) | 0x1F));
}
__device__ __forceinline__ float shx32(float v, int lane) {
    return __builtin_bit_cast(float, __builtin_amdgcn_ds_bpermute((lane ^ 32) << 2, __builtin_bit_cast(int, v)));
}
__device__ __forceinline__ float sum32(float v, int lane) { return v + shx32(v, lane); }
__device__ __forceinline__ float max32(float v, int lane) { return fmaxf(v, shx32(v, lane)); }
namespace pg8 {
#define PG8_LAS __attribute__((address_space(3)))
typedef unsigned short bf16_t;
typedef short bf16x8 __attribute__((ext_vector_type(8)));
typedef float f32x4 __attribute__((ext_vector_type(4)));
typedef unsigned u32x4 __attribute__((ext_vector_type(4)));
constexpr int BM = 256, BK = 64, HALF = 128, HTB = HALF * BK * 2  , STAGE_BYTES = 8 * HTB, NXCD = 8, WGM = 8;

__host__ __device__ __forceinline__ int lds_byte(int r, int c) { const int st = (r >> 4) * 2 + (c >> 5), rr = r & 15, cc = c & 31, ob = rr * 64 + cc * 2; return st * 1024 + (ob ^ (((ob >> 9) & 1) << 5)); }
__host__ __device__ __forceinline__ void stage_rc(int b, int& R, int& C) { const int st = b / 1024, sb = b % 1024, swz = sb ^ (((sb >> 9) & 1) << 5); R = (st >> 1) * 16 + swz / 64; C = (st & 1) * 32 + (swz % 64) / 2; }
__host__ __device__ __forceinline__ int perm32(int rho) { const int n = rho >> 4, i = rho & 15; return 8 * (i >> 2) + 4 * n + (i & 3); }

struct Unit { int pm, pn, ko; };
struct Gemm { const bf16_t* A; const bf16_t* Bt; int M, N, K, ld; };

struct StaticOrder {
    int nM, nN, nwg, G, c;
    __host__ __device__ void init(int M, int N, int G_, int c_) { nM = M / BM; nN = N / BM; nwg = nM * nN; G = G_; c = c_; }
    __host__ __device__ bool next(int i, Unit& u) const {
        const long L = (long)i * G + c; if (L >= nwg) return false;
        int wgid = (int)L; { const int q = nwg / NXCD, r = nwg % NXCD, xcd = wgid % NXCD, off = wgid / NXCD; wgid = (xcd < r ? xcd * (q + 1) : r * (q + 1) + (xcd - r) * q) + off; }
        const int nig = WGM * nN, gid = wgid / nig, fm = gid * WGM, gsz = (nM - fm) < WGM ? (nM - fm) : WGM;
        u.pm = fm + ((wgid % nig) % gsz); u.pn = (wgid % nig) / gsz; u.ko = 0; return true;
    }
    __device__ __forceinline__ void a_ready(const Unit&) const {}
    __device__ __forceinline__ void done(const Unit&) const {}
};


struct SplitOrder {
    int nN, KS, G, c, pmfix, kslice2;
    __host__ __device__ void init(int N, int KS_, int pmfix_, int kslice_elems, int G_, int c_) { nN = N / BM; KS = KS_; G = G_; c = c_; pmfix = pmfix_; kslice2 = kslice_elems * 2; }
    __host__ __device__ bool next(int i, Unit& u) const { const int L = i * G + c; if (L >= nN * KS) return false; u.pm = pmfix; u.pn = L % nN; u.ko = (L / nN) * kslice2; return true; }
    __device__ __forceinline__ void a_ready(const Unit&) const {}
    __device__ __forceinline__ void done(const Unit&) const {}
};
__device__ __forceinline__ unsigned cvt_pk_bf16(float lo, float hi) { unsigned r; asm volatile("v_cvt_pk_bf16_f32 %0, %1, %2" : "=v"(r) : "v"(lo), "v"(hi)); return r; }
typedef float f32x2 __attribute__((ext_vector_type(2)));
typedef unsigned u32x2 __attribute__((ext_vector_type(2)));
constexpr int TOK_P = 16384, TOK_ALL = 16512;
constexpr float LOG2E = 1.4426950408889634f;

struct EpiF32 {
    static constexpr bool PERM = true, AFTER_DRAIN = false;
    float* O; int ldc;
    __device__ __forceinline__ void operator()(const f32x4 (&acc)[2][2][4][2], const Unit& u, int wr, int wc, int fr, int fq) const {
        const int row0 = u.pm * BM + wr * 64 + fr, col0 = u.pn * BM + wc * 32 + 8 * fq;
#pragma unroll
        for (int ai = 0; ai < 2; ++ai)
#pragma unroll
            for (int m = 0; m < 4; ++m) { float* rowp = O + (size_t)(row0 + ai * HALF + m * 16) * ldc + col0;
#pragma unroll
                for (int bj = 0; bj < 2; ++bj) { *(f32x4*)(rowp + bj * HALF) = acc[ai][bj][m][0]; *(f32x4*)(rowp + bj * HALF + 4) = acc[ai][bj][m][1]; } }
    }
};
struct EpiPart {
    static constexpr bool PERM = true, AFTER_DRAIN = false;
    float* P; int ldc; int kslice2;
    __device__ __forceinline__ void operator()(const f32x4 (&acc)[2][2][4][2], const Unit& u, int wr, int wc, int fr, int fq) const {
        const int row0 = wr * 64 + fr, col0 = u.pn * BM + wc * 32 + 8 * fq; float* O = P + (size_t)(u.ko / kslice2) * 256 * ldc;
#pragma unroll
        for (int ai = 0; ai < 1; ++ai)
#pragma unroll
            for (int m = 0; m < 4; ++m) { float* rowp = O + (size_t)(row0 + ai * HALF + m * 16) * ldc + col0;
#pragma unroll
                for (int bj = 0; bj < 2; ++bj) { *(f32x4*)(rowp + bj * HALF) = acc[ai][bj][m][0]; *(f32x4*)(rowp + bj * HALF + 4) = acc[ai][bj][m][1]; } }
    }
};
struct EpiBf16Split {
    static constexpr bool PERM = true, AFTER_DRAIN = false;
    bf16_t* O0; bf16_t* O1; int ldc; int split; float sc;
    __device__ __forceinline__ void operator()(const f32x4 (&acc)[2][2][4][2], const Unit& u, int wr, int wc, int fr, int fq) const {
        int colt = u.pn * BM; bf16_t* base = O0; if (colt >= split) { base = O1; colt -= split; }
        const int row0 = u.pm * BM + wr * 64 + fr, col0 = colt + wc * 32 + 8 * fq;
#pragma unroll
        for (int ai = 0; ai < 2; ++ai)
#pragma unroll
            for (int m = 0; m < 4; ++m) { bf16_t* rowp = base + (size_t)(row0 + ai * HALF + m * 16) * ldc + col0;
#pragma unroll
                for (int bj = 0; bj < 2; ++bj) { const f32x4 v0 = acc[ai][bj][m][0] * sc, v1 = acc[ai][bj][m][1] * sc;
                    u32x4 w; w.x = cvt_pk_bf16(v0[0], v0[1]); w.y = cvt_pk_bf16(v0[2], v0[3]); w.z = cvt_pk_bf16(v1[0], v1[1]); w.w = cvt_pk_bf16(v1[2], v1[3]);
                    *(u32x4*)(rowp + bj * HALF) = w; } }
    }
};
struct EpiSwiglu {
    static constexpr bool PERM = true, AFTER_DRAIN = false;
    bf16_t* O; int ldc;
    __device__ __forceinline__ void operator()(const f32x4 (&acc)[2][2][4][2], const Unit& u, int wr, int wc, int fr, int fq) const {
        const int odd = fq & 1, row0 = u.pm * BM + wr * 64 + fr + odd * 16, col0 = u.pn * 128 + wc * 16 + 8 * (fq >> 1);
#pragma unroll
        for (int ai = 0; ai < 2; ++ai)
#pragma unroll
            for (int bj = 0; bj < 2; ++bj) { u32x2 w[4];
#pragma unroll
                for (int m = 0; m < 4; ++m) { const f32x4 g = acc[ai][bj][m][0], uu = acc[ai][bj][m][1]; float v[4];
#pragma unroll
                    for (int j = 0; j < 4; ++j) v[j] = g[j] * __builtin_amdgcn_rcpf(1.0f + __builtin_amdgcn_exp2f(-g[j] * LOG2E)) * uu[j];
                    w[m].x = cvt_pk_bf16(v[0], v[1]); w[m].y = cvt_pk_bf16(v[2], v[3]); }
#pragma unroll
                for (int p = 0; p < 2; ++p) {
                    const u32x2 snd = odd ? w[2 * p] : w[2 * p + 1], own = odd ? w[2 * p + 1] : w[2 * p];
                    const unsigned r0 = (unsigned)__builtin_amdgcn_ds_swizzle((int)snd.x, (16 << 10) | 0x1F), r1 = (unsigned)__builtin_amdgcn_ds_swizzle((int)snd.y, (16 << 10) | 0x1F);
                    const u32x4 o = odd ? (u32x4){r0, r1, own.x, own.y} : (u32x4){own.x, own.y, r0, r1};
                    *(u32x4*)(O + (size_t)(row0 + ai * HALF + 32 * p) * ldc + col0 + bj * 64) = o; } }
    }
};
struct EpiGateMul {
    static constexpr bool PERM = true, AFTER_DRAIN = false;
    float* O; int ldc;
    __device__ __forceinline__ void operator()(const f32x4 (&acc)[2][2][4][2], const Unit& u, int wr, int wc, int fr, int fq) const {
        const int row0 = u.pm * BM + wr * 64 + fr, col0 = u.pn * BM + wc * 32 + 8 * fq;
#pragma unroll
        for (int ai = 0; ai < 2; ++ai)
#pragma unroll
            for (int m = 0; m < 4; ++m) { float* rowp = O + (size_t)(row0 + ai * HALF + m * 16) * ldc + col0;
#pragma unroll
                for (int bj = 0; bj < 2; ++bj)
#pragma unroll
                    for (int n = 0; n < 2; ++n) { f32x4 o = *(f32x4*)(rowp + bj * HALF + 4 * n); const f32x4 a = acc[ai][bj][m][n];
#pragma unroll
                        for (int j = 0; j < 4; ++j) o[j] *= __builtin_amdgcn_rcpf(1.0f + __builtin_amdgcn_exp2f(-a[j] * LOG2E));
                        *(f32x4*)(rowp + bj * HALF + 4 * n) = o; } }
    }
};
__device__ __forceinline__ int tok_pos(int row) { return row < TOK_P ? (row & 4095) : 2048 + ((row - TOK_P) & 15); }
struct EpiAbIn {
    static constexpr bool PERM = true, AFTER_DRAIN = false;
    float* out;
    bf16_t* q;
    bf16_t* kvp;
    bf16_t* kvs;
    const float* rope;
    long offp, offs;
    float qscale;
    __device__ __forceinline__ void operator()(const f32x4 (&acc)[2][2][4][2], const Unit& u, int wr, int wc, int fr, int fq) const {
        const int seg = u.pn >> 1;
        const int row0 = u.pm * BM + wr * 64 + fr, cs0 = (u.pn & 1) * 256 + wc * 32 + 8 * fq;
        const bool rot = (seg == 3 || seg == 4), isq = (seg == 0 || seg == 3);
        const bool rlane = ((wc & 1) == 0) && (fq < 2);
        const int kvi = (seg == 1) ? 0 : (seg == 2) ? 1 : (seg == 4) ? 2 : 3;
#pragma unroll
        for (int ai = 0; ai < 2; ++ai)
#pragma unroll
            for (int m = 0; m < 4; ++m) {
                const int row = row0 + ai * HALF + m * 16; const int pos = tok_pos(row);
                f32x4 cs_[4];
                if (rot) { const f32x4* rp = (const f32x4*)(rope + (size_t)pos * 16); cs_[0] = rp[0]; cs_[1] = rp[1]; cs_[2] = rp[2]; cs_[3] = rp[3]; }
#pragma unroll
                for (int bj = 0; bj < 2; ++bj) {
                    f32x4 v[2] = {acc[ai][bj][m][0], acc[ai][bj][m][1]};
                    if (rot) {
#pragma unroll
                        for (int n = 0; n < 2; ++n)
#pragma unroll
                            for (int j = 0; j < 4; ++j) { const float own = v[n][j], oth = shx<16>(own); const float c = cs_[n][j], s = cs_[2 + n][j];
                                const float r = (fq == 0) ? own * c - oth * s : own * c + oth * s; if (rlane) v[n][j] = r; }
                    }
                    const int cs = cs0 + bj * 128;
                    if (isq) {
                        bf16_t* qp = q + (seg == 0 ? (size_t)0 : (size_t)16640 * 512) + (size_t)row * 512 + cs;
                        u32x4 w; w.x = cvt_pk_bf16(v[0][0] * qscale, v[0][1] * qscale); w.y = cvt_pk_bf16(v[0][2] * qscale, v[0][3] * qscale);
                        w.z = cvt_pk_bf16(v[1][0] * qscale, v[1][1] * qscale); w.w = cvt_pk_bf16(v[1][2] * qscale, v[1][3] * qscale);
                        *(u32x4*)qp = w;
                    } else if (row < TOK_ALL) {
                        float* op; bf16_t* bp;
                        if (row < TOK_P) { op = out + offp + (size_t)kvi * 8388608 + (size_t)row * 512 + cs; bp = kvp + (size_t)kvi * (16384 * 512) + (size_t)row * 512 + cs; }
                        else { const int rs = row - TOK_P; op = out + offs + (size_t)kvi * 65536 + (size_t)rs * 512 + cs; bp = kvs + (size_t)kvi * (8 * 2112 * 512) + ((size_t)(rs >> 4) * 2112 + 2048 + (rs & 15)) * 512 + cs; }
                        __builtin_nontemporal_store(v[0], (f32x4*)op); __builtin_nontemporal_store(v[1], (f32x4*)(op + 4));
                        u32x4 w; w.x = cvt_pk_bf16(v[0][0], v[0][1]); w.y = cvt_pk_bf16(v[0][2], v[0][3]); w.z = cvt_pk_bf16(v[1][0], v[1][1]); w.w = cvt_pk_bf16(v[1][2], v[1][3]);
                        *(u32x4*)bp = w;
                    }
                }
            }
    }
};

struct RowStat {
    unsigned* xbuf;
    unsigned* cnt;
    unsigned want;
    float inv_n, eps;
    __device__ __forceinline__ void run(const f32x4 (&v)[2][2][4][2], const Unit& u, int wr, int wc, int fr, int fq, PG8_LAS unsigned char* lds, int wid, int lane) const {
        PG8_LAS float* P = (PG8_LAS float*)lds;
        PG8_LAS float* S = (PG8_LAS float*)(lds + 8192);
#pragma unroll
        for (int ai = 0; ai < 2; ++ai)
#pragma unroll
            for (int m = 0; m < 4; ++m) { float s = 0.f;
#pragma unroll
                for (int bj = 0; bj < 2; ++bj)
#pragma unroll
                    for (int n = 0; n < 2; ++n) { const f32x4 x = v[ai][bj][m][n]; s += (x[0] * x[0] + x[1] * x[1]) + (x[2] * x[2] + x[3] * x[3]); }
                s += shx<16>(s); s += shx32(s, lane);
                if (fq == 0) P[(ai * HALF + wr * 64 + m * 16 + fr) * 4 + wc] = s; }
        asm volatile("s_waitcnt lgkmcnt(0)" ::: "memory"); __builtin_amdgcn_s_barrier(); asm volatile("" ::: "memory");
        const int row = wid * 32 + (lane & 31);
        if (lane < 32) { const float t = (P[row * 4 + 0] + P[row * 4 + 1]) + (P[row * 4 + 2] + P[row * 4 + 3]);
            __hip_atomic_store(xbuf + ((size_t)(u.pm * BM + row) * 4 + u.pn), __builtin_bit_cast(unsigned, t), __ATOMIC_RELAXED, __HIP_MEMORY_SCOPE_AGENT); }
        asm volatile("s_waitcnt vmcnt(0)" ::: "memory");
        if (lane == 0) __hip_atomic_fetch_add(cnt + 64 * u.pm, 1u, __ATOMIC_RELAXED, __HIP_MEMORY_SCOPE_AGENT);
        if (wid == 0) {
            unsigned sp = 0;
            for (;;) {
                if ((unsigned)__builtin_amdgcn_readfirstlane(__hip_atomic_load(cnt + 64 * u.pm, __ATOMIC_RELAXED, __HIP_MEMORY_SCOPE_AGENT)) >= want) break;
                if (++sp > (1u << 22)) break;
                __builtin_amdgcn_s_sleep(2);
            }
            __builtin_amdgcn_fence(__ATOMIC_ACQUIRE, "agent");
        }
        asm volatile("s_waitcnt vmcnt(0) lgkmcnt(0)" ::: "memory"); __builtin_amdgcn_s_barrier(); asm volatile("" ::: "memory");
        if (lane < 32) { const unsigned* slot = xbuf + (size_t)(u.pm * BM + row) * 4; float t = 0.f;
#pragma unroll
            for (int q = 0; q < 4; ++q) t += __builtin_bit_cast(float, __hip_atomic_load(slot + q, __ATOMIC_RELAXED, __HIP_MEMORY_SCOPE_AGENT));
            S[row] = 1.0f / sqrtf(t * inv_n + eps); }
        asm volatile("s_waitcnt lgkmcnt(0)" ::: "memory"); __builtin_amdgcn_s_barrier(); asm volatile("" ::: "memory");
    }
};
template <bool GATE, bool HASB> struct EpiRms2 {
    static constexpr bool PERM = true, AFTER_DRAIN = true;
    const float* base; float* out; bf16_t* xn; const float* pin; const float* ga; const float* gb; float coef; RowStat st1, st2;
    __device__ __forceinline__ void fused(f32x4 (&acc)[2][2][4][2], const Unit& u, int wr, int wc, int fr, int fq, PG8_LAS unsigned char* lds, int wid, int lane) const {
        const PG8_LAS float* S = (const PG8_LAS float*)(lds + 8192);
        const int col0 = u.pn * BM + wc * 32 + 8 * fq;
        if (GATE) {
#pragma unroll
            for (int ai = 0; ai < 2; ++ai)
#pragma unroll
                for (int m = 0; m < 4; ++m) { const size_t off = (size_t)(u.pm * BM + ai * HALF + wr * 64 + m * 16 + fr) * 1024 + col0;
#pragma unroll
                    for (int bj = 0; bj < 2; ++bj) {
                        const f32x4 p0 = *(const f32x4*)(pin + off + bj * HALF), p1 = *(const f32x4*)(pin + off + bj * HALF + 4);
                        f32x4 a0 = acc[ai][bj][m][0], a1 = acc[ai][bj][m][1];
#pragma unroll
                        for (int j = 0; j < 4; ++j) { a0[j] = p0[j] * __builtin_amdgcn_rcpf(1.0f + __builtin_amdgcn_exp2f(-a0[j] * LOG2E)); a1[j] = p1[j] * __builtin_amdgcn_rcpf(1.0f + __builtin_amdgcn_exp2f(-a1[j] * LOG2E)); }
                        acc[ai][bj][m][0] = a0; acc[ai][bj][m][1] = a1;
                        asm volatile("" : "+v"(acc[ai][bj][m][0]), "+v"(acc[ai][bj][m][1]) :: "memory");
                    } }
        }
        st1.run(acc, u, wr, wc, fr, fq, lds, wid, lane);
        {   f32x4 g[2][2];
#pragma unroll
            for (int bj = 0; bj < 2; ++bj)
#pragma unroll
                for (int n = 0; n < 2; ++n) g[bj][n] = *(const f32x4*)(ga + col0 + bj * HALF + 4 * n) * coef;
#pragma unroll
            for (int ai = 0; ai < 2; ++ai)
#pragma unroll
                for (int m = 0; m < 4; ++m) { const int r = ai * HALF + wr * 64 + m * 16 + fr; const float s1 = S[r]; const size_t off = (size_t)(u.pm * BM + r) * 1024 + col0;
#pragma unroll
                    for (int bj = 0; bj < 2; ++bj)
#pragma unroll
                        for (int n = 0; n < 2; ++n) { const f32x4 b = *(const f32x4*)(base + off + bj * HALF + 4 * n); acc[ai][bj][m][n] = b + acc[ai][bj][m][n] * g[bj][n] * s1; }
                    asm volatile("" : "+v"(acc[ai][0][m][0]), "+v"(acc[ai][0][m][1]), "+v"(acc[ai][1][m][0]), "+v"(acc[ai][1][m][1]));
                    if (m & 1) asm volatile("" ::: "memory"); }
        }
        if (HASB) st2.run(acc, u, wr, wc, fr, fq, lds, wid, lane);
        {   f32x4 g[2][2];
            if (HASB) {
#pragma unroll
                for (int bj = 0; bj < 2; ++bj)
#pragma unroll
                    for (int n = 0; n < 2; ++n) g[bj][n] = *(const f32x4*)(gb + col0 + bj * HALF + 4 * n);
            }
#pragma unroll
            for (int ai = 0; ai < 2; ++ai)
#pragma unroll
                for (int m = 0; m < 4; ++m) { const int r = ai * HALF + wr * 64 + m * 16 + fr; const float s2 = HASB ? S[r] : 0.f; const size_t off = (size_t)(u.pm * BM + r) * 1024 + col0;
#pragma unroll
                    for (int bj = 0; bj < 2; ++bj) { const f32x4 x0 = acc[ai][bj][m][0], x1 = acc[ai][bj][m][1];
                        *(f32x4*)(out + off + bj * HALF) = x0; *(f32x4*)(out + off + bj * HALF + 4) = x1;
                        if (HASB) { const f32x4 y0 = x0 * g[bj][0] * s2, y1 = x1 * g[bj][1] * s2;
                            u32x4 w; w.x = cvt_pk_bf16(y0[0], y0[1]); w.y = cvt_pk_bf16(y0[2], y0[3]); w.z = cvt_pk_bf16(y1[0], y1[1]); w.w = cvt_pk_bf16(y1[2], y1[3]);
                            *(u32x4*)(xn + off + bj * HALF) = w; } }
                    asm volatile("" ::: "memory"); }
        }
        asm volatile("s_waitcnt lgkmcnt(0)" ::: "memory"); __builtin_amdgcn_s_barrier(); asm volatile("" ::: "memory");
    }
};
template <class Epi, class Sched, bool ALIGN_EPI = false, bool SP2 = false>
__device__ __forceinline__ void gemm_phase(PG8_LAS unsigned char* lds, const Gemm g, const Sched& S, const Epi& E) {
    int tid = threadIdx.x; asm volatile("" : "+v"(tid));
    const int wid = __builtin_amdgcn_readfirstlane(tid >> 6), lane = tid & 63, wr = wid >> 2, wc = wid & 3, fr = lane & 15, fq = lane >> 4;
    const int K = g.ld, nt = g.K / BK;
    unsigned voffA[2], voffB[2];
#pragma unroll
    for (int i = 0; i < 2; ++i) { int R, C; stage_rc(tid * 16 + i * 8192, R, C); const int Rb = Epi::PERM ? ((R & ~31) + perm32(R & 31)) : R;
        voffA[i] = (unsigned)(R * K + C) * 2u; voffB[i] = (unsigned)(Rb * K + C) * 2u; }
    const size_t kstep = (size_t)(BK * 2);
    const size_t hstep = (size_t)HALF * K * 2;
    const size_t tstep = 2 * hstep;
    const unsigned ldsw = (unsigned)wid * 1024u;
    const int aoff = lds_byte(wr * 64 + fr, fq * 8), boff = lds_byte(wc * 32 + fr, fq * 8);
#define PG8_SA(b, h) (((b) * 2 + (h)) * HTB)
#define PG8_SB(b, h) ((4 + (b) * 2 + (h)) * HTB)
#define PG8_STAGE(bufoff, gbase, voff) do { _Pragma("unroll") for (int _i = 0; _i < 2; ++_i) \
        __builtin_amdgcn_global_load_lds((const unsigned*)((const char*)(gbase) + (voff)[_i]), (PG8_LAS unsigned*)(lds + (bufoff) + ldsw + _i * 8192), 16, 0, 0); } while (0)
#define PG8_LDA(dst, b, h) do { _Pragma("unroll") for (int m = 0; m < 4; ++m) _Pragma("unroll") for (int k = 0; k < 2; ++k) dst[m][k] = *(const PG8_LAS bf16x8*)(lds + PG8_SA(b, h) + aoff + m * 2048 + k * 1024); } while (0)
#define PG8_LDB(dst, b, h) do { _Pragma("unroll") for (int n = 0; n < 2; ++n) _Pragma("unroll") for (int k = 0; k < 2; ++k) dst[n][k] = *(const PG8_LAS bf16x8*)(lds + PG8_SB(b, h) + boff + n * 2048 + k * 1024); } while (0)
#define PG8_MMA(ai, bj, At, Bt) do { __builtin_amdgcn_s_setprio(1); _Pragma("unroll") for (int m = 0; m < 4; ++m) _Pragma("unroll") for (int n = 0; n < 2; ++n) _Pragma("unroll") for (int k = 0; k < 2; ++k) \
        acc[ai][bj][m][n] = __builtin_amdgcn_mfma_f32_16x16x32_bf16(Bt[n][k], At[m][k], acc[ai][bj][m][n], 0, 0, 0); __builtin_amdgcn_s_setprio(0); } while (0)
#define PG8_WAIT_V(n) asm volatile("s_waitcnt vmcnt(" #n ")" ::: "memory")
#define PG8_WAIT_L(n) asm volatile("s_waitcnt lgkmcnt(" #n ")" ::: "memory")
#define PG8_BAR __builtin_amdgcn_s_barrier()
#define PG8_SCHED __builtin_amdgcn_sched_barrier(0)
    Unit cur, nxt; int ui = 0;
    if (!S.next(0, cur)) return;
    f32x4 acc[2][2][4][2];
#pragma unroll
    for (int a = 0; a < 2; ++a)
#pragma unroll
        for (int b = 0; b < 2; ++b)
#pragma unroll
            for (int m = 0; m < 4; ++m)
#pragma unroll
                for (int n = 0; n < 2; ++n) acc[a][b][m][n] = (f32x4){0.f, 0.f, 0.f, 0.f};
    bf16x8 At[4][2], B0[2][2], B1[2][2];
    const char* cA = (const char*)g.A + (size_t)cur.pm * tstep + cur.ko; const char* cB = (const char*)g.Bt + (size_t)cur.pn * tstep + cur.ko;
    S.a_ready(cur);
    if constexpr (SP2) {
        PG8_STAGE(PG8_SB(0, 0), cB, voffB); PG8_STAGE(PG8_SB(0, 1), cB + hstep, voffB); PG8_STAGE(PG8_SA(0, 0), cA, voffA); PG8_STAGE(PG8_SA(0, 1), cA + hstep, voffA);
        if (wr == 1) PG8_BAR;
        PG8_WAIT_V(2); PG8_BAR;
        PG8_STAGE(PG8_SB(1, 0), cB + kstep, voffB); PG8_STAGE(PG8_SA(1, 0), cA + kstep, voffA); PG8_STAGE(PG8_SB(1, 1), cB + hstep + kstep, voffB);
        PG8_WAIT_V(6); PG8_BAR;
    } else {
        PG8_STAGE(PG8_SB(0, 0), cB, voffB); PG8_STAGE(PG8_SA(0, 0), cA, voffA); PG8_STAGE(PG8_SB(0, 1), cB + hstep, voffB); PG8_STAGE(PG8_SA(0, 1), cA + hstep, voffA);
        if (wr == 1) PG8_BAR;
        PG8_WAIT_V(4); PG8_BAR;
        PG8_STAGE(PG8_SB(1, 0), cB + kstep, voffB); PG8_STAGE(PG8_SA(1, 0), cA + kstep, voffA); PG8_STAGE(PG8_SB(1, 1), cB + hstep + kstep, voffB);
        PG8_WAIT_V(6); PG8_BAR;
    }
    for (;;) {
        const bool has_next = S.next(ui + 1, nxt);
        const char* nA = has_next ? (const char*)g.A + (size_t)nxt.pm * tstep + nxt.ko : cA; const char* nB = has_next ? (const char*)g.Bt + (size_t)nxt.pn * tstep + nxt.ko : cB;
        for (int t = 0; t < nt; t += 2) {
            const bool last = (t == nt - 2);
            const char* a1 = cA + (size_t)(t + 1) * kstep;
            const char* a2 = last ? nA : cA + (size_t)(t + 2) * kstep; const char* b2 = last ? nB : cB + (size_t)(t + 2) * kstep;
            const char* a3 = a2 + kstep; const char* b3 = b2 + kstep;
            if (last && has_next) S.a_ready(nxt);
            if constexpr (SP2) {
            PG8_LDB(B0, 0, 0); PG8_LDB(B1, 0, 1); PG8_SCHED; PG8_LDA(At, 0, 0); PG8_STAGE(PG8_SA(1, 1), a1 + hstep, voffA);
            PG8_WAIT_V(8); PG8_WAIT_L(0); PG8_BAR; PG8_MMA(0, 0, At, B0); PG8_MMA(0, 1, At, B1); PG8_BAR; PG8_SCHED;
            PG8_LDA(At, 0, 1); PG8_STAGE(PG8_SB(0, 0), b2, voffB); PG8_STAGE(PG8_SB(0, 1), b2 + hstep, voffB); PG8_STAGE(PG8_SA(0, 0), a2, voffA);
            PG8_WAIT_V(8); PG8_WAIT_L(0); PG8_BAR; PG8_MMA(1, 0, At, B0); PG8_MMA(1, 1, At, B1); PG8_BAR; PG8_SCHED;
            PG8_LDB(B0, 1, 0); PG8_LDB(B1, 1, 1); PG8_SCHED; PG8_LDA(At, 1, 0); PG8_STAGE(PG8_SA(0, 1), a2 + hstep, voffA);
            PG8_WAIT_V(8); PG8_WAIT_L(0); PG8_BAR; PG8_MMA(0, 0, At, B0); PG8_MMA(0, 1, At, B1); PG8_BAR; PG8_SCHED;
            PG8_LDA(At, 1, 1); PG8_STAGE(PG8_SB(1, 0), b3, voffB); PG8_STAGE(PG8_SB(1, 1), b3 + hstep, voffB); PG8_STAGE(PG8_SA(1, 0), a3, voffA);
            PG8_WAIT_V(8); PG8_WAIT_L(0); PG8_BAR; PG8_MMA(1, 0, At, B0); PG8_MMA(1, 1, At, B1); PG8_BAR; PG8_SCHED;
            } else {
            PG8_LDB(B0, 0, 0); PG8_SCHED; PG8_LDA(At, 0, 0); PG8_STAGE(PG8_SA(1, 1), a1 + hstep, voffA);
            PG8_WAIT_L(8); PG8_BAR; PG8_WAIT_L(0); PG8_MMA(0, 0, At, B0); PG8_BAR; PG8_SCHED;
            PG8_LDB(B1, 0, 1); PG8_STAGE(PG8_SB(0, 0), b2, voffB);
            PG8_BAR; PG8_WAIT_L(0); PG8_MMA(0, 1, At, B1); PG8_BAR;
            PG8_LDA(At, 0, 1); PG8_STAGE(PG8_SA(0, 0), a2, voffA);
            PG8_BAR; PG8_WAIT_L(0); PG8_MMA(1, 0, At, B0); PG8_BAR; PG8_SCHED;
            PG8_STAGE(PG8_SB(0, 1), b2 + hstep, voffB);
            PG8_WAIT_V(6); PG8_BAR; PG8_MMA(1, 1, At, B1); PG8_BAR;
            PG8_LDB(B0, 1, 0); PG8_SCHED; PG8_LDA(At, 1, 0); PG8_STAGE(PG8_SA(0, 1), a2 + hstep, voffA);
            PG8_WAIT_L(8); PG8_BAR; PG8_WAIT_L(0); PG8_MMA(0, 0, At, B0); PG8_BAR; PG8_SCHED;
            PG8_LDB(B1, 1, 1); PG8_STAGE(PG8_SB(1, 0), b3, voffB);
            PG8_BAR; PG8_WAIT_L(0); PG8_MMA(0, 1, At, B1); PG8_BAR;
            PG8_LDA(At, 1, 1); PG8_STAGE(PG8_SA(1, 0), a3, voffA);
            PG8_BAR; PG8_WAIT_L(0); PG8_MMA(1, 0, At, B0); PG8_BAR; PG8_SCHED;
            PG8_STAGE(PG8_SB(1, 1), b3 + hstep, voffB);
            PG8_WAIT_V(6); PG8_BAR; PG8_MMA(1, 1, At, B1); PG8_BAR;
            }
        }
        if constexpr (ALIGN_EPI) { if (wr == 0) PG8_BAR; }
        if constexpr (!Epi::AFTER_DRAIN) { E(acc, cur, wr, wc, fr, fq); S.done(cur); }
        if (!has_next) break;
#pragma unroll
        for (int a = 0; a < 2; ++a)
#pragma unroll
            for (int b = 0; b < 2; ++b)
#pragma unroll
                for (int m = 0; m < 4; ++m)
#pragma unroll
                    for (int n = 0; n < 2; ++n) acc[a][b][m][n] = (f32x4){0.f, 0.f, 0.f, 0.f};
        cur = nxt; cA = nA; cB = nB; ++ui;
        if constexpr (ALIGN_EPI) { if (wr == 1) PG8_BAR; }
    }
    PG8_WAIT_V(0);
    if constexpr (!ALIGN_EPI) { if (wr == 0) PG8_BAR; }
    PG8_BAR;
    if constexpr (Epi::AFTER_DRAIN) { E.fused(acc, cur, wr, wc, fr, fq, lds, wid, lane); S.done(cur); }
#undef PG8_SA
#undef PG8_SB
#undef PG8_STAGE
#undef PG8_LDA
#undef PG8_LDB
#undef PG8_MMA
#undef PG8_WAIT_V
#undef PG8_WAIT_L
#undef PG8_BAR
#undef PG8_SCHED
}
}

#define LAS __attribute__((address_space(3)))
typedef unsigned short bf16_t;
typedef short bf16x8 __attribute__((ext_vector_type(8)));
typedef short s16x4 __attribute__((ext_vector_type(4)));
typedef float f32x4 __attribute__((ext_vector_type(4)));
typedef float f32x2 __attribute__((ext_vector_type(2)));
typedef float f32x16 __attribute__((ext_vector_type(16)));
typedef unsigned u32x4 __attribute__((ext_vector_type(4)));
typedef unsigned u32x2 __attribute__((ext_vector_type(2)));
using pg8::cvt_pk_bf16; using pg8::TOK_P; using pg8::TOK_ALL; using pg8::LOG2E;

constexpr int MP = 16640;
constexpr int LROWS = 33280;
constexpr int SEQS = 2112;
constexpr float EPS = 1e-6f;
constexpr size_t al256(size_t x) { return (x + 255) & ~(size_t)255; }
constexpr size_t WS_CTL = 0;
constexpr size_t CTL_BYTES = 131072;
constexpr int CW_RS = 16384;
constexpr size_t WS_ROPEDF = 1u << 20;
constexpr size_t WS_ROPEMLA = WS_ROPEDF + 4096 * 16 * 4;
constexpr size_t WS_W0 = 2u << 20;
constexpr size_t SZ_GU = (size_t)5632 * 1024 * 2, SZ_DN = (size_t)1024 * 2816 * 2, SZ_SQ = (size_t)1024 * 1024 * 2, SZ_PLEI = (size_t)1024 * 256 * 2;
constexpr size_t WS_GU = WS_W0;
constexpr size_t WS_DN = WS_GU + 4 * SZ_GU;
constexpr size_t WS_PLEG = WS_DN + 4 * SZ_DN;
constexpr size_t WS_PLEI = WS_PLEG + 2 * SZ_SQ;
constexpr size_t WS_ABIN = WS_PLEI + 2 * SZ_PLEI;
constexpr size_t WS_ABOUT = WS_ABIN + (size_t)3072 * 1024 * 2;
constexpr size_t WS_MLAIN = WS_ABOUT + SZ_SQ;
constexpr size_t WS_UQ = WS_MLAIN + (size_t)768 * 1024 * 2;
constexpr size_t WS_UKV = WS_UQ + (size_t)1536 * 384 * 2;
constexpr size_t WS_MLAOUT = WS_UKV + (size_t)2048 * 256 * 2;
constexpr size_t WS_A = al256(WS_MLAOUT + SZ_SQ);
constexpr size_t WS_PB = WS_A + (size_t)MP * 1024 * 2;
constexpr size_t WS_LAT = WS_PB + (size_t)2 * MP * 256 * 2;
constexpr size_t WS_KR = WS_LAT + (size_t)LROWS * 256 * 2;
constexpr size_t WS_CQ = WS_KR + (size_t)LROWS * 32 * 2;
constexpr size_t WS_BIG = al256(WS_CQ + (size_t)MP * 384 * 2);
constexpr size_t SZ_ACT = (size_t)MP * 2816 * 2, SZ_F = (size_t)MP * 1024 * 4, SZ_SKV1 = (size_t)8 * SEQS * 512 * 2, SZ_KVP1 = (size_t)16384 * 512 * 2;
constexpr size_t WS_ACT = WS_BIG;
constexpr size_t WS_F = WS_BIG + SZ_ACT;
constexpr size_t WS_SKV = WS_F + SZ_F;
constexpr size_t WS_PART = WS_SKV + 4 * SZ_SKV1;
constexpr size_t WS_PIN = WS_PART + (size_t)11 * 256 * 1024 * 4;
constexpr size_t WS_XB = WS_PIN + (size_t)256 * 1024 * 4;
constexpr size_t WS_END = WS_XB + (size_t)2 * 16384 * 4 * 4;
constexpr size_t WS_Q0 = WS_BIG;
constexpr size_t WS_KVP = WS_Q0 + (size_t)2 * MP * 512 * 2;
constexpr size_t WS_DFO = al256(WS_KVP + 4 * SZ_KVP1);
static_assert(WS_DFO + (size_t)2 * MP * 512 * 2 <= WS_SKV, "layer-0 overlay");
constexpr size_t WS_MI = WS_F;
constexpr size_t WS_Q96 = WS_BIG;
constexpr size_t WS_KN = WS_Q96 + (size_t)MP * 1536 * 2;
constexpr size_t WS_VV = WS_KN + (size_t)LROWS * 1024 * 2;
static_assert(WS_VV + (size_t)LROWS * 1024 * 2 <= WS_PART, "layer-1 overlay");
static_assert((size_t)MP * 768 * 4 <= SZ_F, "MI fits F");
constexpr long OUT_SBK_P = 16908288, OUT_LAT_P = 50462720, OUT_KR_P = 54657024, OUT_SBK_S = 55181312, OUT_LAT_S = 55443456, OUT_KR_S = 55476224, OUT_TOTAL = 55480320;

constexpr int LDS_BYTES = 135168;
constexpr int LDS_MISC = 131072;

struct Args { const float* in[28]; float* out; unsigned char* ws; };
__device__ const float INV_DF[8] = {1.0f, 0.193922743f, 0.0376060307f, 0.00729266461f, 0.00141421356f, 0.000274248188f, 5.3182961e-05f, 1.03133862e-05f};
__device__ const float INV_MLA[16] = {1.0f, 0.562341332f, 0.316227764f, 0.177827939f, 0.100000001f, 0.0562341325f, 0.0316227749f, 0.0177827943f, 0.00999999978f, 0.00562341325f, 0.00316227763f, 0.00177827943f, 0.00100000005f, 0.000562341302f, 0.000316227757f, 0.00017782794f};

__device__ __forceinline__ float wave_sum(float v) {
    v += shx<1>(v); v += shx<2>(v); v += shx<4>(v); v += shx<8>(v); v += shx<16>(v);
    return __builtin_bit_cast(float, __builtin_amdgcn_readlane(__builtin_bit_cast(int, v), 0)) + __builtin_bit_cast(float, __builtin_amdgcn_readlane(__builtin_bit_cast(int, v), 32));
}
__device__ __forceinline__ unsigned pk2(float lo, float hi) { return cvt_pk_bf16(lo, hi); }

template <int MAP> __device__ __forceinline__ int wsrc(int v, int N) {
    if (MAP == 1) { const int q8 = v >> 3, r8 = v & 7; return r8 < 4 ? 4 * q8 + r8 : 2816 + 4 * q8 + (r8 - 4); }
    return v < N ? v : -1;
}
template <int MAP> __device__ __forceinline__ void transpose_item(const float* W, int K, int N, int Nv, bf16_t* WT, LAS float* scr, int item, int lane) {
    const int nblk = Nv / 32, kb = item / nblk, nb = item % nblk, k0 = 64 * kb, n0 = 32 * nb;
    const int c4 = lane & 7, kr = lane >> 3;
    const int sc = wsrc<MAP>(n0 + 4 * c4, N);
    f32x4 v[8];
#pragma unroll
    for (int i = 0; i < 8; ++i) v[i] = sc >= 0 ? *(const f32x4*)(W + (size_t)(k0 + 8 * i + kr) * N + sc) : (f32x4){0.f, 0.f, 0.f, 0.f};
#pragma unroll
    for (int i = 0; i < 8; ++i) { LAS float* d = scr + (8 * i + kr) * 33 + 4 * c4; d[0] = v[i][0]; d[1] = v[i][1]; d[2] = v[i][2]; d[3] = v[i][3]; }
    asm volatile("s_waitcnt lgkmcnt(0)" ::: "memory");
    const int c = lane & 7;
#pragma unroll
    for (int j = 0; j < 4; ++j) { const int n = (lane >> 3) + 8 * j; const LAS float* s = scr + (8 * c) * 33 + n;
        u32x4 o; o.x = pk2(s[0 * 33], s[1 * 33]); o.y = pk2(s[2 * 33], s[3 * 33]); o.z = pk2(s[4 * 33], s[5 * 33]); o.w = pk2(s[6 * 33], s[7 * 33]);
        *(u32x4*)(WT + (size_t)(n0 + n) * K + k0 + 8 * c) = o; }
    asm volatile("s_waitcnt lgkmcnt(0)" ::: "memory");
}
__device__ __forceinline__ void cvt_rows(const float* src, bf16_t* dst, int nrows, int width, int spr, int dpr, long gt, long ngt) {
    const int w4 = width >> 2; const long total = (long)nrows * w4;
    constexpr int U = 16;
    for (long q0 = gt; q0 < total; q0 += ngt * U) {
        f32x4 v[U];
#pragma unroll
        for (int u = 0; u < U; ++u) { const long q = q0 + ngt * u; if (q < total) { const int r = (int)(q / w4), c4 = (int)(q % w4); v[u] = __builtin_nontemporal_load((const f32x4*)(src + (size_t)r * width + 4 * c4)); } }
#pragma unroll
        for (int u = 0; u < U; ++u) { const long q = q0 + ngt * u; if (q < total) { const int r = (int)(q / w4), c4 = (int)(q % w4);
            const size_t dr = (size_t)(r / spr) * dpr + (r % spr);
            u32x2 w; w.x = pk2(v[u][0], v[u][1]); w.y = pk2(v[u][2], v[u][3]); *(u32x2*)(dst + dr * width + 4 * c4) = w; } }
    }
}
__device__ __forceinline__ void zero_segs(bf16_t* base, int nseq, size_t stride, int nel, long gt, long ngt) {
    const int n8 = nel >> 3; const long total = (long)nseq * n8;
    for (long q = gt; q < total; q += ngt) { const int s = (int)(q / n8), c = (int)(q % n8); *(u32x4*)(base + (size_t)s * stride + 8 * c) = (u32x4){0u, 0u, 0u, 0u}; }
}
__device__ __forceinline__ void sincos_tab(float ang, float& c, float& s) {
    double rev = (double)ang * 0.15915494309189535; rev -= floor(rev);
    const float rf = (float)rev; c = __builtin_amdgcn_cosf(rf); s = __builtin_amdgcn_sinf(rf);
}

template <bool FIRST, bool HASF, bool HASB, int KSUM = 0, bool GATE = false>
__device__ __forceinline__ void row_phase(const float* xp, const float* xs, float* X, const float* F, const float* ga, float coef, const float* gb, bf16_t* A, const float* part = nullptr, const float* pin = nullptr, int row_first = 0) {
    int t_ = threadIdx.x; asm volatile("" : "+v"(t_));
    const int lane = t_ & 63, gw = blockIdx.x * 8 + __builtin_amdgcn_readfirstlane(t_ >> 6), ngw = gridDim.x * 8;
    for (int row = row_first + gw; row < TOK_ALL; row += ngw) {
        const float* xr = FIRST ? (row < TOK_P ? xp + (size_t)row * 1024 : xs + (size_t)(row - TOK_P) * 1024) : X + (size_t)row * 1024;
        f32x4 x[4];
#pragma unroll
        for (int j = 0; j < 4; ++j) x[j] = ((const f32x4*)xr)[lane + 64 * j];
        if (HASF) {
            f32x4 f[4]; float ss = 0.f;
#pragma unroll
            for (int j = 0; j < 4; ++j) {
                if (KSUM > 0 && row >= TOK_P) {
                    f32x4 s = ((const f32x4*)(part + (size_t)(row - TOK_P) * 1024))[lane + 64 * j];
#pragma unroll
                    for (int k = 1; k < KSUM; ++k) s = s + ((const f32x4*)(part + ((size_t)k * 256 + (row - TOK_P)) * 1024))[lane + 64 * j];
                    if (GATE) { const f32x4 p = ((const f32x4*)(pin + (size_t)(row - TOK_P) * 1024))[lane + 64 * j];
#pragma unroll
                        for (int q = 0; q < 4; ++q) s[q] = p[q] * __builtin_amdgcn_rcpf(1.0f + __builtin_amdgcn_exp2f(-s[q] * LOG2E)); }
                    f[j] = s;
                } else f[j] = ((const f32x4*)(F + (size_t)row * 1024))[lane + 64 * j];
                ss += (f[j][0] * f[j][0] + f[j][1] * f[j][1]) + (f[j][2] * f[j][2] + f[j][3] * f[j][3]); }
            const float r = coef / sqrtf(wave_sum(ss) * (1.f / 1024.f) + EPS);
#pragma unroll
            for (int j = 0; j < 4; ++j) { const f32x4 g = ((const f32x4*)ga)[lane + 64 * j]; x[j] = x[j] + f[j] * g * r; ((f32x4*)(X + (size_t)row * 1024))[lane + 64 * j] = x[j]; }
        }
        if (HASB) {
            float ss = 0.f;
#pragma unroll
            for (int j = 0; j < 4; ++j) ss += (x[j][0] * x[j][0] + x[j][1] * x[j][1]) + (x[j][2] * x[j][2] + x[j][3] * x[j][3]);
            const float r = 1.0f / sqrtf(wave_sum(ss) * (1.f / 1024.f) + EPS);
#pragma unroll
            for (int j = 0; j < 4; ++j) { const f32x4 g = ((const f32x4*)gb)[lane + 64 * j]; const f32x4 y = x[j] * g * r;
                u32x2 w; w.x = pk2(y[0], y[1]); w.y = pk2(y[2], y[3]); ((u32x2*)(A + (size_t)row * 1024))[lane + 64 * j] = w; }
        }
    }
}
__device__ __forceinline__ void mla_row_phase(const float* MI, const float* qn, const float* kvn, const float* rope, bf16_t* CQ, bf16_t* LAT, bf16_t* KR, float* out) {
    int t_ = threadIdx.x; asm volatile("" : "+v"(t_));
    const int lane = t_ & 63, gw = blockIdx.x * 8 + __builtin_amdgcn_readfirstlane(t_ >> 6), ngw = gridDim.x * 8;
    for (int row = gw; row < TOK_ALL; row += ngw) {
        const float* mi = MI + (size_t)row * 768;
        const int lrow = row < TOK_P ? row : TOK_P + ((row - TOK_P) >> 4) * SEQS + 2048 + ((row - TOK_P) & 15);
        {   const f32x4 a = ((const f32x4*)mi)[lane]; const f32x2 b = ((const f32x2*)(mi + 256))[lane];
            const float ss = wave_sum((a[0] * a[0] + a[1] * a[1]) + (a[2] * a[2] + a[3] * a[3]) + (b[0] * b[0] + b[1] * b[1]));
            const float r = 1.0f / sqrtf(ss * (1.f / 384.f) + EPS);
            const f32x4 g = ((const f32x4*)qn)[lane]; const f32x2 g2 = ((const f32x2*)(qn + 256))[lane];
            u32x2 w; w.x = pk2(a[0] * r * g[0], a[1] * r * g[1]); w.y = pk2(a[2] * r * g[2], a[3] * r * g[3]);
            ((u32x2*)(CQ + (size_t)row * 384))[lane] = w; ((unsigned*)(CQ + (size_t)row * 384 + 256))[lane] = pk2(b[0] * r * g2[0], b[1] * r * g2[1]); }
        {   const f32x4 a = ((const f32x4*)(mi + 384))[lane];
            const float ss = wave_sum((a[0] * a[0] + a[1] * a[1]) + (a[2] * a[2] + a[3] * a[3]));
            const float r = 1.0f / sqrtf(ss * (1.f / 256.f) + EPS);
            const f32x4 g = ((const f32x4*)kvn)[lane]; const f32x4 y = a * g * r;
            float* op = row < TOK_P ? out + OUT_LAT_P + (size_t)row * 256 : out + OUT_LAT_S + (size_t)(row - TOK_P) * 256;
            __builtin_nontemporal_store(y, (f32x4*)op + lane);
            u32x2 w; w.x = pk2(y[0], y[1]); w.y = pk2(y[2], y[3]); ((u32x2*)(LAT + (size_t)lrow * 256))[lane] = w; }
        {   const int i = lane & 31; const float v = mi[640 + i]; const float oth = shx<16>(v);
            const int pos = pg8::tok_pos(row); const float c = rope[pos * 32 + (i & 15)], s = rope[pos * 32 + 16 + (i & 15)];
            const float y = (i < 16) ? v * c - oth * s : v * c + oth * s;
            const float yn = shx<1>(y);
            if (lane < 32) { float* op = row < TOK_P ? out + OUT_KR_P + (size_t)row * 32 : out + OUT_KR_S + (size_t)(row - TOK_P) * 32; op[i] = y;
                if ((lane & 1) == 0) ((unsigned*)(KR + (size_t)lrow * 32))[lane >> 1] = pk2(y, yn); } }
    }
}

__device__ __forceinline__ int crow(int r, int hi) { return (r & 3) + 8 * (r >> 2) + 4 * hi; }
__device__ __forceinline__ bf16x8 pack8(const f32x16& p, int b) {
    u32x4 w; w.x = pk2(p[b], p[b + 1]); w.y = pk2(p[b + 2], p[b + 3]); w.z = pk2(p[b + 4], p[b + 5]); w.w = pk2(p[b + 6], p[b + 7]); return __builtin_bit_cast(bf16x8, w);
}
__device__ __forceinline__ s16x4 vtr(const LAS unsigned char* p) { return __builtin_bit_cast(s16x4, __builtin_amdgcn_ds_read_tr16_b64_v4i16((LAS s16x4*)p)); }

template <int DQK, int DV, int MODE, int NCOMP>
__device__ __forceinline__ void attn_unit(LAS unsigned char* lds, const bf16_t* Qp, int ldq, const bf16_t* Kp, int ldk, const bf16_t* K2p, const bf16_t* Vp, int ldv,
                                          bf16_t* Op, int ldo, int nq, int qpos0, int ntiles, int kvalid, float lam, const float* subln) {
    constexpr int RSK = DQK * 2 + 16, RSV = DV * 2 + 64, KOFF = 0, VOFF = 16384, BUFB = 36864  , NS = DQK / 16, ND = DV / 32;
    constexpr int KC = DQK / 8, VC = DV / 8;
    constexpr int NKP = (64 * KC + 511) / 512, NVP = (64 * VC) / 512;
    int tid = threadIdx.x; asm volatile("" : "+v"(tid));
    const int lane = tid & 63, wid = __builtin_amdgcn_readfirstlane(tid >> 6), r32 = lane & 31, hi = lane >> 5;
    const int wq0 = 32 * wid; const bool wactive = wq0 < nq;
    const int qrow = (wq0 + r32 < nq) ? wq0 + r32 : nq - 1;
    const int qpos = qpos0 + wq0 + r32;
    const int cw = wactive ? ((qpos0 + wq0) >> 6) : -1;
    f32x16 osave[ND];
#pragma unroll
    for (int comp = 0; comp < NCOMP; ++comp) {
        bf16x8 qf[NS];
#pragma unroll
        for (int s = 0; s < NS; ++s) qf[s] = *(const bf16x8*)(Qp + (size_t)qrow * ldq + comp * 64 + 16 * s + 8 * hi);
        if (DQK == 96) {
            const float* rp = subln + (size_t)(qpos0 + qrow) * 32 + 8 * hi;
            u32x4 wa, wb;
#pragma unroll
            for (int j2 = 0; j2 < 4; ++j2) { float ra[2], rb[2];
#pragma unroll
                for (int jj = 0; jj < 2; ++jj) { const int j = 2 * j2 + jj;
                    const float x1 = __builtin_bit_cast(float, (unsigned)(unsigned short)qf[NS - 2][j] << 16), x2 = __builtin_bit_cast(float, (unsigned)(unsigned short)qf[NS - 1][j] << 16);
                    const float c = rp[j], s = rp[16 + j]; ra[jj] = x1 * c - x2 * s; rb[jj] = x2 * c + x1 * s; }
                wa[j2] = pk2(ra[0], ra[1]); wb[j2] = pk2(rb[0], rb[1]); }
            qf[NS - 2] = __builtin_bit_cast(bf16x8, wa); qf[NS - 1] = __builtin_bit_cast(bf16x8, wb);
        }
        f32x16 o[ND];
#pragma unroll
        for (int d = 0; d < ND; ++d)
#pragma unroll
            for (int r = 0; r < 16; ++r) o[d][r] = 0.f;
        float m_run = -INFINITY, l_run = 0.f, c_run = 0.f;
        u32x4 kreg[NKP], vreg[NVP];
#define ATT_ISSUE(tile_) do { const int tl_ = (tile_); \
            _Pragma("unroll") for (int i = 0; i < NKP; ++i) { const int pi = tid + 512 * i; if (pi < 64 * KC) { const int key = pi / KC, c = pi % KC; const size_t krow = (size_t)tl_ * 64 + key; \
                    const bf16_t* src = (DQK == 96 && c >= 8) ? K2p + krow * 32 + (c - 8) * 8 : Kp + krow * ldk + comp * 64 + c * 8; \
                    kreg[i] = *(const u32x4*)src; } } \
            _Pragma("unroll") for (int i = 0; i < NVP; ++i) { const int pi = tid + 512 * i; const int key = pi / VC, c = pi % VC; vreg[i] = *(const u32x4*)(Vp + ((size_t)tl_ * 64 + key) * ldv + c * 8); } \
        } while (0)
#define ATT_WRITE(boff_) do { \
            _Pragma("unroll") for (int i = 0; i < NKP; ++i) { const int pi = tid + 512 * i; if (pi < 64 * KC) { const int key = pi / KC, c = pi % KC; *(LAS u32x4*)(lds + (boff_) + KOFF + key * RSK + c * 16) = kreg[i]; } } \
            _Pragma("unroll") for (int i = 0; i < NVP; ++i) { const int pi = tid + 512 * i; const int key = pi / VC, c = pi % VC; *(LAS u32x4*)(lds + (boff_) + VOFF + key * RSV + c * 16) = vreg[i]; } \
        } while (0)
        volatile LAS int* dflag = (volatile LAS int*)(lds + LDS_MISC + 128);
        bool wdone = !wactive;
        ATT_ISSUE(MODE == 1 ? ntiles - 1 : 0);
        ATT_WRITE(0);
        if (ntiles > 1) ATT_ISSUE(MODE == 1 ? ntiles - 2 : 1);
        __syncthreads();
        for (int it = 0; it < ntiles; ++it) {
            const int tile = MODE == 1 ? ntiles - 1 - it : it;
            const int boff = (it & 1) * BUFB;
            if (it + 1 < ntiles) { ATT_WRITE(BUFB - boff); if (it + 2 < ntiles) ATT_ISSUE(MODE == 1 ? tile - 2 : tile + 2); }
            if (tile <= cw) {
                f32x16 p0, p1;
#pragma unroll
                for (int r = 0; r < 16; ++r) { p0[r] = 0.f; p1[r] = 0.f; }
                const LAS unsigned char* kb = lds + boff + KOFF + r32 * RSK + hi * 16;
#pragma unroll
                for (int s = 0; s < NS; ++s) {
                    const bf16x8 a0 = *(const LAS bf16x8*)(kb + s * 32), a1 = *(const LAS bf16x8*)(kb + 32 * RSK + s * 32);
                    p0 = __builtin_amdgcn_mfma_f32_32x32x16_bf16(a0, qf[s], p0, 0, 0, 0);
                    p1 = __builtin_amdgcn_mfma_f32_32x32x16_bf16(a1, qf[s], p1, 0, 0, 0);
                }
                if (MODE == 0) {
                    if (__builtin_expect(tile * 64 + 64 > kvalid, 0)) {
                        asm volatile("" ::: "memory");
#pragma unroll
                        for (int r = 0; r < 16; ++r) { const int kp = tile * 64 + crow(r, hi); if (kp >= kvalid) p0[r] = -INFINITY; if (kp + 32 >= kvalid) p1[r] = -INFINITY; }
                        asm volatile("" : "+v"(p0), "+v"(p1));
                    }
                    float mx = __builtin_fmaxf(__builtin_fmaxf(p0[0], p1[0]), p0[1]);
#pragma unroll
                    for (int r = 1; r < 15; ++r) mx = __builtin_fmaxf(__builtin_fmaxf(mx, p1[r]), p0[r + 1]);
                    mx = __builtin_fmaxf(mx, p1[15]);
                    mx = max32(mx, lane);
                    const float mn = fmaxf(m_run, mx), alpha = __builtin_amdgcn_exp2f(m_run - mn); m_run = mn;
                    {   const f32x2 mn2 = {mn, mn};
#pragma unroll
                        for (int r = 0; r < 16; r += 2) { f32x2 t0 = {p0[r], p0[r + 1]}, t1 = {p1[r], p1[r + 1]}; t0 = t0 - mn2; t1 = t1 - mn2;
                            asm volatile("" : "+v"(t0), "+v"(t1));
                            p0[r] = __builtin_amdgcn_exp2f(t0[0]); p0[r + 1] = __builtin_amdgcn_exp2f(t0[1]); p1[r] = __builtin_amdgcn_exp2f(t1[0]); p1[r + 1] = __builtin_amdgcn_exp2f(t1[1]); } }
                    const f32x16 ps = p0 + p1;
                    const float ls = ((ps[0] + ps[1]) + (ps[2] + ps[3])) + ((ps[4] + ps[5]) + (ps[6] + ps[7])) + (((ps[8] + ps[9]) + (ps[10] + ps[11])) + ((ps[12] + ps[13]) + (ps[14] + ps[15])));
                    l_run = l_run * alpha + ls;
#pragma unroll
                    for (int d = 0; d < ND; ++d) o[d] = o[d] * alpha;
                } else {
                    f32x16 lf0, lf1; float gs[2][4];
#pragma unroll
                    for (int r = 0; r < 16; ++r) {
                        const int kp = tile * 64 + crow(r, hi);
                        const float z0 = p0[r], z1 = p1[r];
                        const float s0 = fmaxf(z0, 0.f) + __builtin_amdgcn_logf(1.0f + __builtin_amdgcn_exp2f(-fabsf(z0)));
                        const float s1 = fmaxf(z1, 0.f) + __builtin_amdgcn_logf(1.0f + __builtin_amdgcn_exp2f(-fabsf(z1)));
                        lf0[r] = (kp < qpos) ? -s0 : 0.f; lf1[r] = (kp + 32 < qpos) ? -s1 : 0.f;
                    }
#pragma unroll
                    for (int g = 0; g < 4; ++g) { gs[0][g] = (lf0[4 * g] + lf0[4 * g + 1]) + (lf0[4 * g + 2] + lf0[4 * g + 3]); gs[1][g] = (lf1[4 * g] + lf1[4 * g + 1]) + (lf1[4 * g + 2] + lf1[4 * g + 3]); }
                    float running = c_run;
#pragma unroll
                    for (int kh = 1; kh >= 0; --kh)
#pragma unroll
                        for (int g = 3; g >= 0; --g) {
                            const float pg = shx32(gs[kh][g], lane);
                            float b = running + (hi ? 0.f : pg);
#pragma unroll
                            for (int e = 3; e >= 0; --e) {
                                const int r = 4 * g + e; const int kp = tile * 64 + 32 * kh + crow(r, hi);
                                const float z = kh ? p1[r] : p0[r], lfv = kh ? lf1[r] : lf0[r];
                                const float w = (kp < qpos) ? __builtin_amdgcn_exp2f(z + lfv + b) : 0.f;
                                b += lfv;
                                if (kh) p1[r] = w; else p0[r] = w;
                            }
                            running += gs[kh][g] + pg;
                        }
                    c_run = running;
                    wdone = (__builtin_amdgcn_ballot_w64(c_run > -160.f) == 0ull);
                }
                const bf16x8 pb0 = pack8(p0, 0), pb1 = pack8(p0, 8), pb2 = pack8(p1, 0), pb3 = pack8(p1, 8);
                const LAS unsigned char* vb = lds + boff + VOFF + (4 * hi + ((lane & 15) >> 2)) * RSV + ((lane >> 4) & 1) * 32 + (lane & 3) * 8;
#pragma unroll
                for (int d = 0; d < ND; ++d) {
#pragma unroll
                    for (int ks = 0; ks < 4; ++ks) {
                        const s16x4 lo = vtr(vb + (16 * ks) * RSV + d * 64), hh = vtr(vb + (16 * ks + 8) * RSV + d * 64);
                        const bf16x8 vf = (bf16x8){lo[0], lo[1], lo[2], lo[3], hh[0], hh[1], hh[2], hh[3]};
                        const bf16x8 pb = ks == 0 ? pb0 : ks == 1 ? pb1 : ks == 2 ? pb2 : pb3;
                        o[d] = __builtin_amdgcn_mfma_f32_32x32x16_bf16(vf, pb, o[d], 0, 0, 0);
                    }
                }
            }
            if (MODE == 1 && lane == 0) dflag[(it & 1) * 8 + wid] = wdone ? 1 : 0;
            __syncthreads();
            if (MODE == 1) { int all = 1;
#pragma unroll
                for (int w = 0; w < 8; ++w) all &= dflag[(it & 1) * 8 + w];
                if (all) break; }
        }
        if (MODE == 0) {
            const float lt = sum32(l_run, lane); const float inv = 1.0f / lt;
#pragma unroll
            for (int d = 0; d < ND; ++d)
#pragma unroll
                for (int r = 0; r < 16; ++r) o[d][r] *= inv;
        }
        if (NCOMP == 2 && comp == 0) {
#pragma unroll
            for (int d = 0; d < ND; ++d) osave[d] = o[d];
        } else {
            if (NCOMP == 2) {
                float ss = 0.f;
#pragma unroll
                for (int d = 0; d < ND; ++d)
#pragma unroll
                    for (int r = 0; r < 16; ++r) { o[d][r] = osave[d][r] - lam * o[d][r]; ss += o[d][r] * o[d][r]; }
                ss = sum32(ss, lane);
                const float rn = 0.8f / sqrtf(ss * (1.f / DV) + EPS);
#pragma unroll
                for (int d = 0; d < ND; ++d)
#pragma unroll
                    for (int g = 0; g < 4; ++g) { const f32x4 sg = *(const f32x4*)(subln + 32 * d + 8 * g + 4 * hi);
#pragma unroll
                        for (int e = 0; e < 4; ++e) o[d][4 * g + e] *= rn * sg[e]; }
            }
            if (wq0 + r32 < nq) {
                bf16_t* orow = Op + (size_t)(wq0 + r32) * ldo;
#pragma unroll
                for (int d = 0; d < ND; ++d)
#pragma unroll
                    for (int g = 0; g < 4; ++g) { u32x2 w; w.x = pk2(o[d][4 * g], o[d][4 * g + 1]); w.y = pk2(o[d][4 * g + 2], o[d][4 * g + 3]); *(u32x2*)(orow + 32 * d + 8 * g + 4 * hi) = w; }
            }
        }
    }
}

__device__ __forceinline__ int next_unit(unsigned* ctr, volatile LAS int* slot) {
    __syncthreads();
    if (threadIdx.x == 0) *slot = (int)atomicAdd(ctr, 1u);
    __syncthreads();
    return *slot;
}

template <class Epi> __device__ __forceinline__ void run_gemm(LAS unsigned char* lds, const bf16_t* A, const bf16_t* Bt, int M, int N, int K, const Epi& E) {
    pg8::Gemm g{A, Bt, M, N, K, K}; pg8::StaticOrder S; S.init(M, N, (int)gridDim.x, (int)blockIdx.x);
    pg8::gemm_phase<Epi, pg8::StaticOrder, true, true>(lds, g, S, E);
}
template <class Epi> __device__ __forceinline__ void run_gemm_fused(LAS unsigned char* lds, const bf16_t* A, const bf16_t* Bt, int K, const Epi& E) {
    pg8::Gemm g{A, Bt, TOK_P, 1024, K, K}; pg8::StaticOrder S; S.init(TOK_P, 1024, (int)gridDim.x, (int)blockIdx.x);
    pg8::gemm_phase<Epi, pg8::StaticOrder, false, true>(lds, g, S, E);
}
template <class Epi> __device__ __forceinline__ void run_gemm_split(LAS unsigned char* lds, const bf16_t* A, const bf16_t* Bt, int N, int K, int KS, const Epi& E) {
    pg8::Gemm g{A, Bt, 256, N, K / KS, K}; pg8::SplitOrder S; S.init(N, KS, TOK_P / 256, K / KS, (int)gridDim.x, (int)blockIdx.x);
    pg8::gemm_phase<Epi, pg8::SplitOrder, true, true>(lds, g, S, E);
}

#define OPQ() unsigned char* w_ = ws; asm volatile("" : "+s"(w_)); float* out_ = out; asm volatile("" : "+s"(out_))
#define ctl ((unsigned*)(w_ + WS_CTL))
#define ropedf ((float*)(w_ + WS_ROPEDF))
#define ropemla ((float*)(w_ + WS_ROPEMLA))
#define Abuf ((bf16_t*)(w_ + WS_A))
#define PB ((bf16_t*)(w_ + WS_PB))
#define LAT ((bf16_t*)(w_ + WS_LAT))
#define KR ((bf16_t*)(w_ + WS_KR))
#define CQ ((bf16_t*)(w_ + WS_CQ))
#define ACT ((bf16_t*)(w_ + WS_ACT))
#define F ((float*)(w_ + WS_F))
#define SKV ((bf16_t*)(w_ + WS_SKV))
#define Q0 ((bf16_t*)(w_ + WS_Q0))
#define KVP ((bf16_t*)(w_ + WS_KVP))
#define DFO ((bf16_t*)(w_ + WS_DFO))
#define MI ((float*)(w_ + WS_MI))
#define Q96 ((bf16_t*)(w_ + WS_Q96))
#define KN ((bf16_t*)(w_ + WS_KN))
#define VV ((bf16_t*)(w_ + WS_VV))
#define WSB(off) ((const bf16_t*)(w_ + (off)))
#define PART ((float*)(w_ + WS_PART))
#define PIN ((float*)(w_ + WS_PIN))
#define RSTAT(k_) pg8::RowStat{(unsigned*)(w_ + WS_XB + (size_t)(((k_) & 1) ^ 1) * 16384 * 16), (unsigned*)(w_ + WS_CTL) + CW_RS, 32u * (unsigned)(k_), 1.0f / 1024.0f, EPS}
#define XK(site_) ((l * 4 + (site_)) * 2 + 1)


constexpr int CW_BAR = 4096;
#define XB_TMO      128
#define XB_XCNT(j)  (256  + 64 * (j))
#define XB_XSUB(j)  (1280 + 64 * (j))
#define XB_XGEN(j)  (2304 + 64 * (j))
#define XB_TOP      3328
#define XB_TOPGEN   3392
#define XCD_BAR_WORDS 3456
#define XB_SPIN_CAP (1u << 18)

__device__ __forceinline__ unsigned xb_ld(unsigned* p)              { return __hip_atomic_load(p, __ATOMIC_RELAXED, __HIP_MEMORY_SCOPE_AGENT); }
__device__ __forceinline__ unsigned xb_add(unsigned* p, unsigned v) { return __hip_atomic_fetch_add(p, v, __ATOMIC_RELAXED, __HIP_MEMORY_SCOPE_AGENT); }
__device__ __forceinline__ unsigned xb_xcc_id() { return (unsigned)__builtin_amdgcn_s_getreg((3 << 11) | 20) & 0xFu; }
#define XB_SPIN(cond, bar) do { unsigned _sp = 0; while (cond) { __builtin_amdgcn_s_sleep(1); \
    if ((++_sp & 255u) == 0u) { if (xb_ld(&(bar)[XB_TMO])) break; if (_sp > XB_SPIN_CAP) { atomicAdd(&(bar)[XB_TMO], 1u); break; } } } } while (0)

struct XcdBarrier {
    unsigned* bar; unsigned x;
    volatile LAS unsigned* st;
};

__device__ __forceinline__ XcdBarrier xcd_barrier_post(unsigned* bar, volatile LAS unsigned* st) {
    XcdBarrier b; b.bar = bar; b.x = xb_xcc_id(); b.st = st;
    if (threadIdx.x == 0) (void)xb_add(&bar[XB_XCNT(b.x)], 1u);
    return b;
}
__device__ __forceinline__ void xcd_barrier_complete(unsigned* bar, unsigned x, unsigned& nloc, unsigned& nx) {
    const unsigned G = gridDim.x * gridDim.y * gridDim.z;
    unsigned sum, cnt, mine, sp = 0u;
    for (;;) {
        sum = 0u; cnt = 0u; mine = 0u;
#pragma unroll
        for (unsigned j = 0; j < 16; ++j) { const unsigned c = xb_ld(&bar[XB_XCNT(j)]); sum += c; cnt += (c > 0u) ? 1u : 0u; mine = (j == x) ? c : mine; }
        if (sum == G) break;
        __builtin_amdgcn_s_sleep(1);
        if ((++sp & 255u) == 0u) { if (xb_ld(&bar[XB_TMO])) break; if (sp > XB_SPIN_CAP) { atomicAdd(&bar[XB_TMO], 1u); break; } }
    }
    nloc = mine > 0u ? mine : 1u; nx = cnt > 0u ? cnt : 1u;
}

__device__ __forceinline__ void xcd_barrier(const XcdBarrier& b) {
    asm volatile("s_waitcnt vmcnt(0)" ::: "memory");
    __syncthreads();
    if (threadIdx.x == 0) {
        unsigned* bar = b.bar;
        __builtin_amdgcn_s_waitcnt(0);
        unsigned nloc = b.st[0], nx = b.st[1];
        if (nloc == 0u) { xcd_barrier_complete(bar, b.x, nloc, nx); b.st[0] = nloc; b.st[1] = nx; }
        const unsigned old = xb_add(&bar[XB_XSUB(b.x)], 1u);
        const unsigned gen = old / nloc;
        if (old + 1u == (gen + 1u) * nloc) {
            __builtin_amdgcn_fence(__ATOMIC_RELEASE, "agent");
            asm volatile("s_waitcnt vmcnt(0)" ::: "memory");
            const unsigned og = xb_add(&bar[XB_TOP], 1u);
            const unsigned tg = og / nx;
            if (og + 1u == (tg + 1u) * nx) xb_add(&bar[XB_TOPGEN], 1u);
            else XB_SPIN(xb_ld(&bar[XB_TOPGEN]) == tg, bar);
            __builtin_amdgcn_fence(__ATOMIC_ACQUIRE, "agent");
            xb_add(&bar[XB_XGEN(b.x)], 1u);
            asm volatile("s_waitcnt vmcnt(0)" ::: "memory");
        } else {
            XB_SPIN(xb_ld(&bar[XB_XGEN(b.x)]) == gen, bar);
            __builtin_amdgcn_fence(__ATOMIC_ACQUIRE, "agent");
            asm volatile("s_waitcnt vmcnt(0)" ::: "memory");
        }
    }
    __syncthreads();
}

template <int l> __device__ __forceinline__ void layer_body(const Args& a, LAS unsigned char* lds, unsigned char* ws, float* out, const float* norms, volatile LAS int* slot, const XcdBarrier& bar) {
        const float* g = norms + (size_t)l * 8 * 1024;
        { OPQ(); pg8::EpiSwiglu E{ACT, 2816}; run_gemm(lds, Abuf, WSB(WS_GU + (size_t)(l * 2 + 0) * SZ_GU), MP, 5632, 1024, E); }
        xcd_barrier(bar);
        { OPQ(); pg8::EpiRms2<false, true> E{l == 0 ? a.in[0] : (const float*)out_, out_, Abuf, nullptr, g + 1024, g + 2048, 0.5f, RSTAT(XK(0)), RSTAT(XK(0) + 1)};
          run_gemm_fused(lds, ACT, WSB(WS_DN + (size_t)(l * 2 + 0) * SZ_DN), 2816, E); }
        { OPQ(); pg8::EpiPart E{PART, 1024, 512}; run_gemm_split(lds, ACT, WSB(WS_DN + (size_t)(l * 2 + 0) * SZ_DN), 1024, 2816, 11, E); }
        xcd_barrier(bar);
        { OPQ(); if (l == 0) row_phase<true, true, true, 11>(a.in[0], a.in[1], out_, F, g + 1024, 0.5f, g + 2048, Abuf, PART, nullptr, TOK_P);
          else row_phase<false, true, true, 11>(nullptr, nullptr, out_, F, g + 1024, 0.5f, g + 2048, Abuf, PART, nullptr, TOK_P); }
        xcd_barrier(bar);
        if (l == 0) {
            { OPQ(); pg8::EpiAbIn E{out_, Q0, KVP, SKV, ropedf, OUT_SBK_P, OUT_SBK_S, 0.125f * LOG2E};
              run_gemm(lds, Abuf, WSB(WS_ABIN), MP, 3072, 1024, E); }
            xcd_barrier(bar);
            {   OPQ();
                const float* lv = a.in[19];
                int tl_ = threadIdx.x; asm volatile("" : "+v"(tl_)); const int lane = tl_ & 63;
                const float d01 = wave_sum(lv[lane] * lv[64 + lane]), d23 = wave_sum(lv[128 + lane] * lv[192 + lane]);
                const float lam = expf(d01) - expf(d23) + 0.2f;
                const size_t PSZ = (size_t)16384 * 512, SSZ = (size_t)8 * SEQS * 512;
                const int rep_ = 0;
                for (;;) {
                    const int u = next_unit(ctl + 0 + 128 * rep_, slot);
                    if (u >= 1152) break;
                    int type, qb = 0, idx;
                    if (u < 256) { type = 0; qb = 15 - u / 32; idx = u % 32; }
                    else if (u < 320) { type = 1; idx = u - 256; }
                    else if (u < 576) { type = 0; qb = 7 - (u - 320) / 32; idx = (u - 320) % 32; }
                    else if (u < 1088) { type = 2; qb = 15 - (u - 576) / 32; idx = (u - 576) % 32; }
                    else { type = 3; idx = u - 1088; }
                    const bool smp = (type & 1) != 0;
                    if (type < 2) {
                        const int comp = idx & 1, bh = idx >> 1, b = bh >> 2, h = bh & 3;
                        const size_t row0 = smp ? (size_t)TOK_P + 16 * b : (size_t)b * 4096 + 256 * qb;
                        const bf16_t* Kb = smp ? SKV + 2 * SSZ + (size_t)b * SEQS * 512 : KVP + 2 * PSZ + (size_t)b * 4096 * 512;
                        const bf16_t* Vb = smp ? SKV + 3 * SSZ + (size_t)b * SEQS * 512 : KVP + 3 * PSZ + (size_t)b * 4096 * 512;
                        attn_unit<64, 128, 0, 1>(lds, Q0 + (size_t)MP * 512 + row0 * 512 + h * 128 + comp * 64, 512, Kb + h * 128 + comp * 64, 512, nullptr, Vb + h * 128, 512,
                                                 DFO + (size_t)comp * MP * 512 + row0 * 512 + h * 128, 512, smp ? 16 : 256, smp ? 2048 : 256 * qb, smp ? 33 : 4 * qb + 4, smp ? 2064 : (1 << 30), 0.f, nullptr);
                    } else {
                        const int b = idx >> 3, h = idx & 7;
                        const size_t row0 = smp ? (size_t)TOK_P + 16 * b : (size_t)b * 4096 + 256 * qb;
                        const bf16_t* Kb = smp ? SKV + (size_t)b * SEQS * 512 : KVP + (size_t)b * 4096 * 512;
                        const bf16_t* Vb = smp ? SKV + SSZ + (size_t)b * SEQS * 512 : KVP + PSZ + (size_t)b * 4096 * 512;
                        attn_unit<64, 64, 1, 1>(lds, Q0 + row0 * 512 + h * 64, 512, Kb + h * 64, 512, nullptr, Vb + h * 64, 512,
                                                Abuf + row0 * 1024 + h * 64, 1024, smp ? 16 : 256, smp ? 2048 : 256 * qb, smp ? 33 : 4 * qb + 4, 1 << 30, 0.f, nullptr);
                    }
                }
                (void)lam;
            }
            xcd_barrier(bar);
            {
                OPQ(); int t_ = threadIdx.x; asm volatile("" : "+v"(t_));
                const int lane = t_ & 63, gw = blockIdx.x * 8 + __builtin_amdgcn_readfirstlane(t_ >> 6), ngw = gridDim.x * 8;
                const float* lv = a.in[19];
                const float d01 = wave_sum(lv[lane] * lv[64 + lane]), d23 = wave_sum(lv[128 + lane] * lv[192 + lane]);
                const float lam = expf(d01) - expf(d23) + 0.2f;
                const f32x2 sg = ((const f32x2*)a.in[20])[lane];
                for (int it = gw; it < TOK_ALL * 4; it += ngw) { const int row = it >> 2, h = it & 3;
                    const unsigned w1 = ((const unsigned*)(DFO + (size_t)row * 512 + h * 128))[lane], w2 = ((const unsigned*)(DFO + (size_t)MP * 512 + (size_t)row * 512 + h * 128))[lane];
                    const float a0 = __builtin_bit_cast(float, w1 << 16) - lam * __builtin_bit_cast(float, w2 << 16), a1 = __builtin_bit_cast(float, w1 & 0xffff0000u) - lam * __builtin_bit_cast(float, w2 & 0xffff0000u);
                    const float rn = 0.8f / sqrtf(wave_sum(a0 * a0 + a1 * a1) * (1.f / 128.f) + EPS);
                    ((unsigned*)(Abuf + (size_t)row * 1024 + 512 + h * 128))[lane] = pk2(a0 * rn * sg[0], a1 * rn * sg[1]); }
            }
            xcd_barrier(bar);
            { OPQ(); pg8::EpiRms2<false, true> E{out_, out_, Abuf, nullptr, g + 3 * 1024, g + 4 * 1024, 1.0f, RSTAT(XK(1)), RSTAT(XK(1) + 1)}; run_gemm_fused(lds, Abuf, WSB(WS_ABOUT), 1024, E); }
            { OPQ(); pg8::EpiPart E{PART, 1024, 512}; run_gemm_split(lds, Abuf, WSB(WS_ABOUT), 1024, 1024, 4, E); }
        } else {
            { OPQ(); pg8::EpiF32 E{MI, 768}; run_gemm(lds, Abuf, WSB(WS_MLAIN), MP, 768, 1024, E); }
            xcd_barrier(bar);
            { OPQ(); mla_row_phase(MI, a.in[22], a.in[23], ropemla, CQ, LAT, KR, out_); }
            xcd_barrier(bar);
            { OPQ(); pg8::EpiBf16Split E{KN, VV, 1024, 1024, 1.0f}; run_gemm(lds, LAT, WSB(WS_UKV), LROWS, 2048, 256, E); }
            { OPQ(); pg8::EpiBf16Split E{Q96, Q96, 1536, 1 << 30, 0.10206207261596577f * LOG2E}; run_gemm(lds, CQ, WSB(WS_UQ), MP, 1536, 384, E); }
            xcd_barrier(bar);
            { OPQ();
            const int rep_ = 0;
            for (;;) {
                const int u = next_unit(ctl + 64 + 128 * rep_, slot);
                if (u >= 1152) break;
                bool smp = false; int qb = 0, idx;
                if (u < 512) { qb = 15 - u / 64; idx = u % 64; }
                else if (u < 640) { smp = true; idx = u - 512; }
                else { qb = 7 - (u - 640) / 64; idx = (u - 640) % 64; }
                const int b = idx >> 4, h = idx & 15;
                const size_t row0 = smp ? (size_t)TOK_P + 16 * b : (size_t)b * 4096 + 256 * qb;
                const size_t krow0 = smp ? (size_t)TOK_P + (size_t)b * SEQS : (size_t)b * 4096;
                attn_unit<96, 64, 0, 1>(lds, Q96 + row0 * 1536 + h * 96, 1536, KN + krow0 * 1024 + h * 64, 1024, KR + krow0 * 32, VV + krow0 * 1024 + h * 64, 1024,
                                        Abuf + row0 * 1024 + h * 64, 1024, smp ? 16 : 256, smp ? 2048 : 256 * qb, smp ? 33 : 4 * qb + 4, smp ? 2064 : (1 << 30), 0.f, ropemla);
            } }
            xcd_barrier(bar);
            { OPQ(); pg8::EpiRms2<false, true> E{out_, out_, Abuf, nullptr, g + 3 * 1024, g + 4 * 1024, 1.0f, RSTAT(XK(1)), RSTAT(XK(1) + 1)}; run_gemm_fused(lds, Abuf, WSB(WS_MLAOUT), 1024, E); }
            { OPQ(); pg8::EpiPart E{PART, 1024, 512}; run_gemm_split(lds, Abuf, WSB(WS_MLAOUT), 1024, 1024, 4, E); }
        }
        xcd_barrier(bar);
        { OPQ(); row_phase<false, true, true, 4>(nullptr, nullptr, out_, F, g + 3 * 1024, 1.0f, g + 4 * 1024, Abuf, PART, nullptr, TOK_P); }
        xcd_barrier(bar);
        { OPQ(); pg8::EpiSwiglu E{ACT, 2816}; run_gemm(lds, Abuf, WSB(WS_GU + (size_t)(l * 2 + 1) * SZ_GU), MP, 5632, 1024, E); }
        xcd_barrier(bar);
        { OPQ(); pg8::EpiRms2<false, true> E{out_, out_, Abuf, nullptr, g + 5 * 1024, g + 6 * 1024, 0.5f, RSTAT(XK(2)), RSTAT(XK(2) + 1)};
          run_gemm_fused(lds, ACT, WSB(WS_DN + (size_t)(l * 2 + 1) * SZ_DN), 2816, E); }
        { OPQ(); pg8::EpiPart E{PART, 1024, 512}; run_gemm_split(lds, ACT, WSB(WS_DN + (size_t)(l * 2 + 1) * SZ_DN), 1024, 2816, 11, E); }
        xcd_barrier(bar);
        { OPQ(); row_phase<false, true, true, 11>(nullptr, nullptr, out_, F, g + 5 * 1024, 0.5f, g + 6 * 1024, Abuf, PART, nullptr, TOK_P); }
        xcd_barrier(bar);
        { OPQ(); pg8::EpiF32 E{F, 1024}; run_gemm(lds, PB + (size_t)l * MP * 256, WSB(WS_PLEI + (size_t)l * SZ_PLEI), TOK_P, 1024, 256, E); }
        { OPQ(); if (l == 0) { pg8::EpiRms2<true, true> E{out_, out_, Abuf, F, g + 7 * 1024, g + 8 * 1024, 1.0f, RSTAT(XK(3)), RSTAT(XK(3) + 1)}; run_gemm_fused(lds, Abuf, WSB(WS_PLEG + (size_t)l * SZ_SQ), 1024, E); }
          else { pg8::EpiRms2<true, false> E{out_, out_, nullptr, F, g + 7 * 1024, nullptr, 1.0f, RSTAT(XK(3)), RSTAT(XK(3) + 1)}; run_gemm_fused(lds, Abuf, WSB(WS_PLEG + (size_t)l * SZ_SQ), 1024, E); } }
        { OPQ(); pg8::EpiPart E{PIN, 1024, 512}; run_gemm_split(lds, PB + (size_t)l * MP * 256, WSB(WS_PLEI + (size_t)l * SZ_PLEI), 1024, 256, 1, E); }
        { OPQ(); pg8::EpiPart E{PART, 1024, 512}; run_gemm_split(lds, Abuf, WSB(WS_PLEG + (size_t)l * SZ_SQ), 1024, 1024, 4, E); }
        xcd_barrier(bar);
        { OPQ(); if (l == 0) row_phase<false, true, true, 4, true>(nullptr, nullptr, out_, F, g + 7 * 1024, 1.0f, g + 8 * 1024, Abuf, PART, PIN, TOK_P);
          else row_phase<false, true, false, 4, true>(nullptr, nullptr, out_, F, g + 7 * 1024, 1.0f, nullptr, nullptr, PART, PIN, TOK_P); }
        if (l == 0) xcd_barrier(bar);
}

__global__ void __launch_bounds__(512) fwd_megakernel(Args a) {
    extern __shared__ __attribute__((aligned(16))) unsigned char lds_raw[];
    LAS unsigned char* lds = (LAS unsigned char*)lds_raw;
    cg::grid_group grid = cg::this_grid();
    unsigned char* ws = a.ws; float* out = a.out;
    const float* norms = a.in[10];
    volatile LAS int* slot = (volatile LAS int*)(lds + LDS_MISC);
    volatile LAS unsigned* bst = (volatile LAS unsigned*)(lds + LDS_MISC + 64);
    if (threadIdx.x < 2) bst[threadIdx.x] = 0u;
    __syncthreads();
    const XcdBarrier bar = xcd_barrier_post((unsigned*)(ws + WS_CTL) + CW_BAR, bst);

    {
        OPQ();
        int tid = threadIdx.x; asm volatile("" : "+v"(tid));
        const int lane = tid & 63, wave = __builtin_amdgcn_readfirstlane(tid >> 6);
        const int G = gridDim.x, gw = blockIdx.x * 8 + wave, ngw = G * 8;
        const long gt = (long)blockIdx.x * 512 + tid, ngt = (long)G * 512;
        LAS float* scr = (LAS float*)(lds + wave * 16384);
        int base = 0;
#define TR(MAP, src, dst, K_, N_, Nv_) do { const int items_ = ((K_) / 64) * ((Nv_) / 32); \
            for (int it_ = (gw + ngw - (base % ngw)) % ngw; it_ < items_; it_ += ngw) transpose_item<MAP>((src), (K_), (N_), (Nv_), (bf16_t*)(dst), scr, it_, lane); base += items_; } while (0)
        for (int l = 0; l < 2; ++l) {
            TR(1, a.in[11] + (size_t)l * 1024 * 5632, w_ + WS_GU + (size_t)(l * 2 + 0) * SZ_GU, 1024, 5632, 5632);
            TR(1, a.in[13] + (size_t)l * 1024 * 5632, w_ + WS_GU + (size_t)(l * 2 + 1) * SZ_GU, 1024, 5632, 5632);
            TR(0, a.in[12] + (size_t)l * 2816 * 1024, w_ + WS_DN + (size_t)(l * 2 + 0) * SZ_DN, 2816, 1024, 1024);
            TR(0, a.in[14] + (size_t)l * 2816 * 1024, w_ + WS_DN + (size_t)(l * 2 + 1) * SZ_DN, 2816, 1024, 1024);
            TR(0, a.in[16] + (size_t)l * 1024 * 1024, w_ + WS_PLEG + (size_t)l * SZ_SQ, 1024, 1024, 1024);
            TR(0, a.in[15] + (size_t)l * 256 * 1024, w_ + WS_PLEI + (size_t)l * SZ_PLEI, 256, 1024, 1024);
        }
        TR(0, a.in[17], w_ + WS_ABIN, 1024, 3072, 3072);
        TR(0, a.in[18], w_ + WS_ABOUT, 1024, 1024, 1024);
        TR(0, a.in[21], w_ + WS_MLAIN, 1024, 672, 768);
        TR(0, a.in[24], w_ + WS_UQ, 384, 1536, 1536);
        TR(0, a.in[25], w_ + WS_UKV, 256, 1024, 1024);
        TR(0, a.in[26], w_ + WS_UKV + (size_t)1024 * 256 * 2, 256, 1024, 1024);
        TR(0, a.in[27], w_ + WS_MLAOUT, 1024, 1024, 1024);
#undef TR
        cvt_rows(a.in[4], SKV + (size_t)0 * (8 * SEQS * 512), 16384, 512, 2048, SEQS, gt, ngt);
        cvt_rows(a.in[5], SKV + (size_t)1 * (8 * SEQS * 512), 16384, 512, 2048, SEQS, gt, ngt);
        cvt_rows(a.in[6], SKV + (size_t)2 * (8 * SEQS * 512), 16384, 512, 2048, SEQS, gt, ngt);
        cvt_rows(a.in[7], SKV + (size_t)3 * (8 * SEQS * 512), 16384, 512, 2048, SEQS, gt, ngt);
        cvt_rows(a.in[8], LAT + (size_t)TOK_P * 256, 16384, 256, 2048, SEQS, gt, ngt);
        cvt_rows(a.in[9], KR + (size_t)TOK_P * 32, 16384, 32, 2048, SEQS, gt, ngt);
        for (int l = 0; l < 2; ++l) {
            cvt_rows(a.in[2] + (size_t)l * 16384 * 256, PB + (size_t)l * MP * 256, 16384, 256, 1 << 30, 0, gt, ngt);
            cvt_rows(a.in[3] + (size_t)l * 128 * 256, PB + (size_t)l * MP * 256 + (size_t)TOK_P * 256, 128, 256, 1 << 30, 0, gt, ngt);
            zero_segs(PB + (size_t)l * MP * 256 + (size_t)TOK_ALL * 256, 1, 0, 128 * 256, gt, ngt);
        }
        for (int i = 0; i < 4; ++i) zero_segs(SKV + (size_t)i * (8 * SEQS * 512) + (size_t)2064 * 512, 8, (size_t)SEQS * 512, 48 * 512, gt, ngt);
        zero_segs(LAT + ((size_t)TOK_P + 2064) * 256, 8, (size_t)SEQS * 256, 48 * 256, gt, ngt);
        zero_segs(KR + ((size_t)TOK_P + 2064) * 32, 8, (size_t)SEQS * 32, 48 * 32, gt, ngt);
        zero_segs(Abuf + (size_t)TOK_ALL * 1024, 1, 0, 128 * 1024, gt, ngt);
        zero_segs(CQ + (size_t)TOK_ALL * 384, 1, 0, 128 * 384, gt, ngt);
        for (long i = gt; i < 4096 * 8; i += ngt) { const int pos = (int)(i >> 3), k = (int)(i & 7); float c, s; sincos_tab((float)pos * INV_DF[k], c, s); ropedf[pos * 16 + k] = c; ropedf[pos * 16 + 8 + k] = s; }
        for (long i = gt; i < 4096 * 16; i += ngt) { const int pos = (int)(i >> 4), k = (int)(i & 15); float c, s; sincos_tab((float)pos * INV_MLA[k], c, s); ropemla[pos * 32 + k] = c; ropemla[pos * 32 + 16 + k] = s; }
        row_phase<true, false, true>(a.in[0], a.in[1], nullptr, nullptr, nullptr, 0.f, norms, Abuf);
    }
    grid.sync();

    layer_body<0>(a, lds, ws, out, norms, slot, bar);
    layer_body<1>(a, lds, ws, out, norms, slot, bar);
}

extern "C" void kernel_launch(void* const* d_in, const int* in_sizes, int n_in, void* d_out, int out_size, void* d_ws, size_t ws_size, hipStream_t stream) {
    static int grid = 0;
    if (grid == 0) {
        if (n_in != 28 || out_size != (int)OUT_TOTAL || ws_size < WS_END) { fprintf(stderr, "kernel_launch: unexpected shapes (n_in %d out %d ws %zu need %zu)\n", n_in, out_size, ws_size, (size_t)WS_END); grid = -1; return; }
        int dev = 0, cus = 0, per_cu = 0;
        hipGetDevice(&dev); hipDeviceGetAttribute(&cus, hipDeviceAttributeMultiprocessorCount, dev);
        hipFuncSetAttribute((const void*)fwd_megakernel, hipFuncAttributeMaxDynamicSharedMemorySize, LDS_BYTES);
        hipOccupancyMaxActiveBlocksPerMultiprocessor(&per_cu, (const void*)fwd_megakernel, 512, LDS_BYTES);
        if (per_cu < 1) { fprintf(stderr, "kernel_launch: occupancy query says %d blocks per CU\n", per_cu); per_cu = 1; }
        grid = 256;
        if (cus < 256) { fprintf(stderr, "kernel_launch: needs a 256-CU device (got %d)\n", cus); grid = -1; return; }
        (void)hipGetLastError();
    }
    if (grid < 0) return;
    hipMemsetAsync((char*)d_ws + WS_CTL, 0, CTL_BYTES, stream);
    Args a{};
    for (int i = 0; i < 28; ++i) a.in[i] = (const float*)d_in[i];
    a.out = (float*)d_out; a.ws = (unsigned char*)d_ws;
    void* args[] = {&a};
    hipError_t e = hipLaunchCooperativeKernel((const void*)fwd_megakernel, dim3(grid), dim3(512), args, LDS_BYTES, stream);
    if (e != hipSuccess) fprintf(stderr, "cooperative launch failed: %s (grid %d)\n", hipGetErrorString(e), grid);
}
```

```cpp
#include <hip/hip_runtime.h>
#include <hip/hip_cooperative_groups.h>
#include <cstdio>
#include <cstdint>
#include <cmath>
namespace cg = cooperative_groups;

template <int MASK> __device__ __forceinline__ float shx(float v) {
    static_assert(MASK > 0 && MASK < 32, "shx: xor mask 1..31");
    return __builtin_bit_cast(float, __builtin_amdgcn_ds_swizzle(__builtin_bit_cast(int, v), (MASK << 10) | 0x1F));
}
__device__ __forceinline__ float shx32(float v, int lane) {
    return __builtin_bit_cast(float, __builtin_amdgcn_ds_bpermute((lane ^ 32) << 2, __builtin_bit_cast(int, v)));
}
__device__ __forceinline__ float sum32(float v, int lane) { return v + shx32(v, lane); }
__device__ __forceinline__ float max32(float v, int lane) { return fmaxf(v, shx32(v, lane)); }
namespace pg8 {
#define PG8_LAS __attribute__((address_space(3)))
typedef unsigned short bf16_t;
typedef short bf16x8 __attribute__((ext_vector_type(8)));
typedef float f32x4 __attribute__((ext_vector_type(4)));
typedef unsigned u32x4 __attribute__((ext_vector_type(4)));
constexpr int BM = 256, BK = 64, HALF = 128, HTB = HALF * BK * 2  , STAGE_BYTES = 8 * HTB, NXCD = 8, WGM = 8;

__host__ __device__ __forceinline__ int lds_byte(int r, int c) { const int st = (r >> 4) * 2 + (c >> 5), rr = r & 15, cc = c & 31, ob = rr * 64 + cc * 2; return st * 1024 + (ob ^ (((ob >> 9) & 1) << 5)); }
__host__ __device__ __forceinline__ void stage_rc(int b, int& R, int& C) { const int st = b / 1024, sb = b % 1024, swz = sb ^ (((sb >> 9) & 1) << 5); R = (st >> 1) * 16 + swz / 64; C = (st & 1) * 32 + (swz % 64) / 2; }
__host__ __device__ __forceinline__ int perm32(int rho) { const int n = rho >> 4, i = rho & 15; return 8 * (i >> 2) + 4 * n + (i & 3); }

struct Unit { int pm, pn, ko; };
struct Gemm { const bf16_t* A; const bf16_t* Bt; int M, N, K, ld; };

struct StaticOrder {
    int nM, nN, nwg, G, c;
    __host__ __device__ void init(int M, int N, int G_, int c_) { nM = M / BM; nN = N / BM; nwg = nM * nN; G = G_; c = c_; }
    __host__ __device__ bool next(int i, Unit& u) const {
        const long L = (long)i * G + c; if (L >= nwg) return false;
        int wgid = (int)L; { const int q = nwg / NXCD, r = nwg % NXCD, xcd = wgid % NXCD, off = wgid / NXCD; wgid = (xcd < r ? xcd * (q + 1) : r * (q + 1) + (xcd - r) * q) + off; }
        const int nig = WGM * nN, gid = wgid / nig, fm = gid * WGM, gsz = (nM - fm) < WGM ? (nM - fm) : WGM;
        u.pm = fm + ((wgid % nig) % gsz); u.pn = (wgid % nig) / gsz; u.ko = 0; return true;
    }
    __device__ __forceinline__ void a_ready(const Unit&) const {}
    __device__ __forceinline__ void done(const Unit&) const {}
};


struct SplitOrder {
    int nN, KS, G, c, pmfix, kslice2;
    __host__ __device__ void init(int N, int KS_, int pmfix_, int kslice_elems, int G_, int c_) { nN = N / BM; KS = KS_; G = G_; c = c_; pmfix = pmfix_; kslice2 = kslice_elems * 2; }
    __host__ __device__ bool next(int i, Unit& u) const { const int L = i * G + c; if (L >= nN * KS) return false; u.pm = pmfix; u.pn = L % nN; u.ko = (L / nN) * kslice2; return true; }
    __device__ __forceinline__ void a_ready(const Unit&) const {}
    __device__ __forceinline__ void done(const Unit&) const {}
};
__device__ __forceinline__ unsigned cvt_pk_bf16(float lo, float hi) { unsigned r; asm volatile("v_cvt_pk_bf16_f32 %0, %1, %2" : "=v"(r) : "v"(lo), "v"(hi)); return r; }
typedef float f32x2 __attribute__((ext_vector_type(2)));
typedef unsigned u32x2 __attribute__((ext_vector_type(2)));
constexpr int TOK_P = 16384, TOK_ALL = 16512;
constexpr float LOG2E = 1.4426950408889634f;

struct EpiF32 {
    static constexpr bool PERM = true, AFTER_DRAIN = false;
    float* O; int ldc;
    __device__ __forceinline__ void operator()(const f32x4 (&acc)[2][2][4][2], const Unit& u, int wr, int wc, int fr, int fq) const {
        const int row0 = u.pm * BM + wr * 64 + fr, col0 = u.pn * BM + wc * 32 + 8 * fq;
#pragma unroll
        for (int ai = 0; ai < 2; ++ai)
#pragma unroll
            for (int m = 0; m < 4; ++m) { float* rowp = O + (size_t)(row0 + ai * HALF + m * 16) * ldc + col0;
#pragma unroll
                for (int bj = 0; bj < 2; ++bj) { *(f32x4*)(rowp + bj * HALF) = acc[ai][bj][m][0]; *(f32x4*)(rowp + bj * HALF + 4) = acc[ai][bj][m][1]; } }
    }
};
struct EpiPart {
    static constexpr bool PERM = true, AFTER_DRAIN = false;
    float* P; int ldc; int kslice2;
    __device__ __forceinline__ void operator()(const f32x4 (&acc)[2][2][4][2], const Unit& u, int wr, int wc, int fr, int fq) const {
        const int row0 = wr * 64 + fr, col0 = u.pn * BM + wc * 32 + 8 * fq; float* O = P + (size_t)(u.ko / kslice2) * 256 * ldc;
#pragma unroll
        for (int ai = 0; ai < 1; ++ai)
#pragma unroll
            for (int m = 0; m < 4; ++m) { float* rowp = O + (size_t)(row0 + ai * HALF + m * 16) * ldc + col0;
#pragma unroll
                for (int bj = 0; bj < 2; ++bj) { *(f32x4*)(rowp + bj * HALF) = acc[ai][bj][m][0]; *(f32x4*)(rowp + bj * HALF + 4) = acc[ai][bj][m][1]; } }
    }
};
struct EpiBf16Split {
    static constexpr bool PERM = true, AFTER_DRAIN = false;
    bf16_t* O0; bf16_t* O1; int ldc; int split; float sc;
    __device__ __forceinline__ void operator()(const f32x4 (&acc)[2][2][4][2], const Unit& u, int wr, int wc, int fr, int fq) const {
        int colt = u.pn * BM; bf16_t* base = O0; if (colt >= split) { base = O1; colt -= split; }
        const int row0 = u.pm * BM + wr * 64 + fr, col0 = colt + wc * 32 + 8 * fq;
#pragma unroll
        for (int ai = 0; ai < 2; ++ai)
#pragma unroll
            for (int m = 0; m < 4; ++m) { bf16_t* rowp = base + (size_t)(row0 + ai * HALF + m * 16) * ldc + col0;
#pragma unroll
                for (int bj = 0; bj < 2; ++bj) { const f32x4 v0 = acc[ai][bj][m][0] * sc, v1 = acc[ai][bj][m][1] * sc;
                    u32x4 w; w.x = cvt_pk_bf16(v0[0], v0[1]); w.y = cvt_pk_bf16(v0[2], v0[3]); w.z = cvt_pk_bf16(v1[0], v1[1]); w.w = cvt_pk_bf16(v1[2], v1[3]);
                    *(u32x4*)(rowp + bj * HALF) = w; } }
    }
};
struct EpiSwiglu {
    static constexpr bool PERM = true, AFTER_DRAIN = false;
    bf16_t* O; int ldc;
    __device__ __forceinline__ void operator()(const f32x4 (&acc)[2][2][4][2], const Unit& u, int wr, int wc, int fr, int fq) const {
        const int odd = fq & 1, row0 = u.pm * BM + wr * 64 + fr + odd * 16, col0 = u.pn * 128 + wc * 16 + 8 * (fq >> 1);
#pragma unroll
        for (int ai = 0; ai < 2; ++ai)
#pragma unroll
            for (int bj = 0; bj < 2; ++bj) { u32x2 w[4];
#pragma unroll
                for (int m = 0; m < 4; ++m) { const f32x4 g = acc[ai][bj][m][0], uu = acc[ai][bj][m][1]; float v[4];
#pragma unroll
                    for (int j = 0; j < 4; ++j) v[j] = g[j] * __builtin_amdgcn_rcpf(1.0f + __builtin_amdgcn_exp2f(-g[j] * LOG2E)) * uu[j];
                    w[m].x = cvt_pk_bf16(v[0], v[1]); w[m].y = cvt_pk_bf16(v[2], v[3]); }
#pragma unroll
                for (int p = 0; p < 2; ++p) {
                    const u32x2 snd = odd ? w[2 * p] : w[2 * p + 1], own = odd ? w[2 * p + 1] : w[2 * p];
                    const unsigned r0 = (unsigned)__builtin_amdgcn_ds_swizzle((int)snd.x, (16 << 10) | 0x1F), r1 = (unsigned)__builtin_amdgcn_ds_swizzle((int)snd.y, (16 << 10) | 0x1F);
                    const u32x4 o = odd ? (u32x4){r0, r1, own.x, own.y} : (u32x4){own.x, own.y, r0, r1};
                    *(u32x4*)(O + (size_t)(row0 + ai * HALF + 32 * p) * ldc + col0 + bj * 64) = o; } }
    }
};
struct EpiGateMul {
    static constexpr bool PERM = true, AFTER_DRAIN = false;
    float* O; int ldc;
    __device__ __forceinline__ void operator()(const f32x4 (&acc)[2][2][4][2], const Unit& u, int wr, int wc, int fr, int fq) const {
        const int row0 = u.pm * BM + wr * 64 + fr, col0 = u.pn * BM + wc * 32 + 8 * fq;
#pragma unroll
        for (int ai = 0; ai < 2; ++ai)
#pragma unroll
            for (int m = 0; m < 4; ++m) { float* rowp = O + (size_t)(row0 + ai * HALF + m * 16) * ldc + col0;
#pragma unroll
                for (int bj = 0; bj < 2; ++bj)
#pragma unroll
                    for (int n = 0; n < 2; ++n) { f32x4 o = *(f32x4*)(rowp + bj * HALF + 4 * n); const f32x4 a = acc[ai][bj][m][n];
#pragma unroll
                        for (int j = 0; j < 4; ++j) o[j] *= __builtin_amdgcn_rcpf(1.0f + __builtin_amdgcn_exp2f(-a[j] * LOG2E));
                        *(f32x4*)(rowp + bj * HALF + 4 * n) = o; } }
    }
};
__device__ __forceinline__ int tok_pos(int row) { return row < TOK_P ? (row & 4095) : 2048 + ((row - TOK_P) & 15); }
struct EpiAbIn {
    static constexpr bool PERM = true, AFTER_DRAIN = false;
    float* out;
    bf16_t* q;
    bf16_t* kvp;
    bf16_t* kvs;
    const float* rope;
    long offp, offs;
    float qscale;
    __device__ __forceinline__ void operator()(const f32x4 (&acc)[2][2][4][2], const Unit& u, int wr, int wc, int fr, int fq) const {
        const int seg = u.pn >> 1;
        const int row0 = u.pm * BM + wr * 64 + fr, cs0 = (u.pn & 1) * 256 + wc * 32 + 8 * fq;
        const bool rot = (seg == 3 || seg == 4), isq = (seg == 0 || seg == 3);
        const bool rlane = ((wc & 1) == 0) && (fq < 2);
        const int kvi = (seg == 1) ? 0 : (seg == 2) ? 1 : (seg == 4) ? 2 : 3;
#pragma unroll
        for (int ai = 0; ai < 2; ++ai)
#pragma unroll
            for (int m = 0; m < 4; ++m) {
                const int row = row0 + ai * HALF + m * 16; const int pos = tok_pos(row);
                f32x4 cs_[4];
                if (rot) { const f32x4* rp = (const f32x4*)(rope + (size_t)pos * 16); cs_[0] = rp[0]; cs_[1] = rp[1]; cs_[2] = rp[2]; cs_[3] = rp[3]; }
#pragma unroll
                for (int bj = 0; bj < 2; ++bj) {
                    f32x4 v[2] = {acc[ai][bj][m][0], acc[ai][bj][m][1]};
                    if (rot) {
#pragma unroll
                        for (int n = 0; n < 2; ++n)
#pragma unroll
                            for (int j = 0; j < 4; ++j) { const float own = v[n][j], oth = shx<16>(own); const float c = cs_[n][j], s = cs_[2 + n][j];
                                const float r = (fq == 0) ? own * c - oth * s : own * c + oth * s; if (rlane) v[n][j] = r; }
                    }
                    const int cs = cs0 + bj * 128;
                    if (isq) {
                        bf16_t* qp = q + (seg == 0 ? (size_t)0 : (size_t)16640 * 512) + (size_t)row * 512 + cs;
                        u32x4 w; w.x = cvt_pk_bf16(v[0][0] * qscale, v[0][1] * qscale); w.y = cvt_pk_bf16(v[0][2] * qscale, v[0][3] * qscale);
                        w.z = cvt_pk_bf16(v[1][0] * qscale, v[1][1] * qscale); w.w = cvt_pk_bf16(v[1][2] * qscale, v[1][3] * qscale);
                        *(u32x4*)qp = w;
                    } else if (row < TOK_ALL) {
                        float* op; bf16_t* bp;
                        if (row < TOK_P) { op = out + offp + (size_t)kvi * 8388608 + (size_t)row * 512 + cs; bp = kvp + (size_t)kvi * (16384 * 512) + (size_t)row * 512 + cs; }
                        else { const int rs = row - TOK_P; op = out + offs + (size_t)kvi * 65536 + (size_t)rs * 512 + cs; bp = kvs + (size_t)kvi * (8 * 2112 * 512) + ((size_t)(rs >> 4) * 2112 + 2048 + (rs & 15)) * 512 + cs; }
                        __builtin_nontemporal_store(v[0], (f32x4*)op); __builtin_nontemporal_store(v[1], (f32x4*)(op + 4));
                        u32x4 w; w.x = cvt_pk_bf16(v[0][0], v[0][1]); w.y = cvt_pk_bf16(v[0][2], v[0][3]); w.z = cvt_pk_bf16(v[1][0], v[1][1]); w.w = cvt_pk_bf16(v[1][2], v[1][3]);
                        *(u32x4*)bp = w;
                    }
                }
            }
    }
};

struct RowStat {
    unsigned* xbuf;
    unsigned* cnt;
    unsigned want;
    float inv_n, eps;
    __device__ __forceinline__ void run(const f32x4 (&v)[2][2][4][2], const Unit& u, int wr, int wc, int fr, int fq, PG8_LAS unsigned char* lds, int wid, int lane) const {
        PG8_LAS float* P = (PG8_LAS float*)lds;
        PG8_LAS float* S = (PG8_LAS float*)(lds + 8192);
#pragma unroll
        for (int ai = 0; ai < 2; ++ai)
#pragma unroll
            for (int m = 0; m < 4; ++m) { float s = 0.f;
#pragma unroll
                for (int bj = 0; bj < 2; ++bj)
#pragma unroll
                    for (int n = 0; n < 2; ++n) { const f32x4 x = v[ai][bj][m][n]; s += (x[0] * x[0] + x[1] * x[1]) + (x[2] * x[2] + x[3] * x[3]); }
                s += shx<16>(s); s += shx32(s, lane);
                if (fq == 0) P[(ai * HALF + wr * 64 + m * 16 + fr) * 4 + wc] = s; }
        asm volatile("s_waitcnt lgkmcnt(0)" ::: "memory"); __builtin_amdgcn_s_barrier(); asm volatile("" ::: "memory");
        const int row = wid * 32 + (lane & 31);
        if (lane < 32) { const float t = (P[row * 4 + 0] + P[row * 4 + 1]) + (P[row * 4 + 2] + P[row * 4 + 3]);
            __hip_atomic_store(xbuf + ((size_t)(u.pm * BM + row) * 4 + u.pn), __builtin_bit_cast(unsigned, t), __ATOMIC_RELAXED, __HIP_MEMORY_SCOPE_AGENT); }
        asm volatile("s_waitcnt vmcnt(0)" ::: "memory");
        if (lane == 0) __hip_atomic_fetch_add(cnt + 64 * u.pm, 1u, __ATOMIC_RELAXED, __HIP_MEMORY_SCOPE_AGENT);
        if (wid == 0) {
            unsigned sp = 0;
            for (;;) {
                if ((unsigned)__builtin_amdgcn_readfirstlane(__hip_atomic_load(cnt + 64 * u.pm, __ATOMIC_RELAXED, __HIP_MEMORY_SCOPE_AGENT)) >= want) break;
                if (++sp > (1u << 22)) break;
                __builtin_amdgcn_s_sleep(2);
            }
            __builtin_amdgcn_fence(__ATOMIC_ACQUIRE, "agent");
        }
        asm volatile("s_waitcnt vmcnt(0) lgkmcnt(0)" ::: "memory"); __builtin_amdgcn_s_barrier(); asm volatile("" ::: "memory");
        if (lane < 32) { const unsigned* slot = xbuf + (size_t)(u.pm * BM + row) * 4; float t = 0.f;
#pragma unroll
            for (int q = 0; q < 4; ++q) t += __builtin_bit_cast(float, __hip_atomic_load(slot + q, __ATOMIC_RELAXED, __HIP_MEMORY_SCOPE_AGENT));
            S[row] = 1.0f / sqrtf(t * inv_n + eps); }
        asm volatile("s_waitcnt lgkmcnt(0)" ::: "memory"); __builtin_amdgcn_s_barrier(); asm volatile("" ::: "memory");
    }
};
template <bool GATE, bool HASB> struct EpiRms2 {
    static constexpr bool PERM = true, AFTER_DRAIN = true;
    const float* base; float* out; bf16_t* xn; const float* pin; const float* ga; const float* gb; float coef; RowStat st1, st2;
    __device__ __forceinline__ void fused(f32x4 (&acc)[2][2][4][2], const Unit& u, int wr, int wc, int fr, int fq, PG8_LAS unsigned char* lds, int wid, int lane) const {
        const PG8_LAS float* S = (const PG8_LAS float*)(lds + 8192);
        const int col0 = u.pn * BM + wc * 32 + 8 * fq;
        if (GATE) {
#pragma unroll
            for (int ai = 0; ai < 2; ++ai)
#pragma unroll
                for (int m = 0; m < 4; ++m) { const size_t off = (size_t)(u.pm * BM + ai * HALF + wr * 64 + m * 16 + fr) * 1024 + col0;
#pragma unroll
                    for (int bj = 0; bj < 2; ++bj) {
                        const f32x4 p0 = *(const f32x4*)(pin + off + bj * HALF), p1 = *(const f32x4*)(pin + off + bj * HALF + 4);
                        f32x4 a0 = acc[ai][bj][m][0], a1 = acc[ai][bj][m][1];
#pragma unroll
                        for (int j = 0; j < 4; ++j) { a0[j] = p0[j] * __builtin_amdgcn_rcpf(1.0f + __builtin_amdgcn_exp2f(-a0[j] * LOG2E)); a1[j] = p1[j] * __builtin_amdgcn_rcpf(1.0f + __builtin_amdgcn_exp2f(-a1[j] * LOG2E)); }
                        acc[ai][bj][m][0] = a0; acc[ai][bj][m][1] = a1;
                        asm volatile("" : "+v"(acc[ai][bj][m][0]), "+v"(acc[ai][bj][m][1]) :: "memory");
                    } }
        }
        st1.run(acc, u, wr, wc, fr, fq, lds, wid, lane);
        {   f32x4 g[2][2];
#pragma unroll
            for (int bj = 0; bj < 2; ++bj)
#pragma unroll
                for (int n = 0; n < 2; ++n) g[bj][n] = *(const f32x4*)(ga + col0 + bj * HALF + 4 * n) * coef;
#pragma unroll
            for (int ai = 0; ai < 2; ++ai)
#pragma unroll
                for (int m = 0; m < 4; ++m) { const int r = ai * HALF + wr * 64 + m * 16 + fr; const float s1 = S[r]; const size_t off = (size_t)(u.pm * BM + r) * 1024 + col0;
#pragma unroll
                    for (int bj = 0; bj < 2; ++bj)
#pragma unroll
                        for (int n = 0; n < 2; ++n) { const f32x4 b = *(const f32x4*)(base + off + bj * HALF + 4 * n); acc[ai][bj][m][n] = b + acc[ai][bj][m][n] * g[bj][n] * s1; }
                    asm volatile("" : "+v"(acc[ai][0][m][0]), "+v"(acc[ai][0][m][1]), "+v"(acc[ai][1][m][0]), "+v"(acc[ai][1][m][1]));
                    if (m & 1) asm volatile("" ::: "memory"); }
        }
        if (HASB) st2.run(acc, u, wr, wc, fr, fq, lds, wid, lane);
        {   f32x4 g[2][2];
            if (HASB) {
#pragma unroll
                for (int bj = 0; bj < 2; ++bj)
#pragma unroll
                    for (int n = 0; n < 2; ++n) g[bj][n] = *(const f32x4*)(gb + col0 + bj * HALF + 4 * n);
            }
#pragma unroll
            for (int ai = 0; ai < 2; ++ai)
#pragma unroll
                for (int m = 0; m < 4; ++m) { const int r = ai * HALF + wr * 64 + m * 16 + fr; const float s2 = HASB ? S[r] : 0.f; const size_t off = (size_t)(u.pm * BM + r) * 1024 + col0;
#pragma unroll
                    for (int bj = 0; bj < 2; ++bj) { const f32x4 x0 = acc[ai][bj][m][0], x1 = acc[ai][bj][m][1];
                        *(f32x4*)(out + off + bj * HALF) = x0; *(f32x4*)(out + off + bj * HALF + 4) = x1;
                        if (HASB) { const f32x4 y0 = x0 * g[bj][0] * s2, y1 = x1 * g[bj][1] * s2;
                            u32x4 w; w.x = cvt_pk_bf16(y0[0], y0[1]); w.y = cvt_pk_bf16(y0[2], y0[3]); w.z = cvt_pk_bf16(y1[0], y1[1]); w.w = cvt_pk_bf16(y1[2], y1[3]);
                            *(u32x4*)(xn + off + bj * HALF) = w; } }
                    asm volatile("" ::: "memory"); }
        }
        asm volatile("s_waitcnt lgkmcnt(0)" ::: "memory"); __builtin_amdgcn_s_barrier(); asm volatile("" ::: "memory");
    }
};
template <class Epi, class Sched, bool ALIGN_EPI = false, bool SP2 = false>
__device__ __forceinline__ void gemm_phase(PG8_LAS unsigned char* lds, const Gemm g, const Sched& S, const Epi& E) {
    int tid = threadIdx.x; asm volatile("" : "+v"(tid));
    const int wid = __builtin_amdgcn_readfirstlane(tid >> 6), lane = tid & 63, wr = wid >> 2, wc = wid & 3, fr = lane & 15, fq = lane >> 4;
    const int K = g.ld, nt = g.K / BK;
    unsigned voffA[2], voffB[2];
#pragma unroll
    for (int i = 0; i < 2; ++i) { int R, C; stage_rc(tid * 16 + i * 8192, R, C); const int Rb = Epi::PERM ? ((R & ~31) + perm32(R & 31)) : R;
        voffA[i] = (unsigned)(R * K + C) * 2u; voffB[i] = (unsigned)(Rb * K + C) * 2u; }
    const size_t kstep = (size_t)(BK * 2);
    const size_t hstep = (size_t)HALF * K * 2;
    const size_t tstep = 2 * hstep;
    const unsigned ldsw = (unsigned)wid * 1024u;
    const int aoff = lds_byte(wr * 64 + fr, fq * 8), boff = lds_byte(wc * 32 + fr, fq * 8);
#define PG8_SA(b, h) (((b) * 2 + (h)) * HTB)
#define PG8_SB(b, h) ((4 + (b) * 2 + (h)) * HTB)
#define PG8_STAGE(bufoff, gbase, voff) do { _Pragma("unroll") for (int _i = 0; _i < 2; ++_i) \
        __builtin_amdgcn_global_load_lds((const unsigned*)((const char*)(gbase) + (voff)[_i]), (PG8_LAS unsigned*)(lds + (bufoff) + ldsw + _i * 8192), 16, 0, 0); } while (0)
#define PG8_LDA(dst, b, h) do { _Pragma("unroll") for (int m = 0; m < 4; ++m) _Pragma("unroll") for (int k = 0; k < 2; ++k) dst[m][k] = *(const PG8_LAS bf16x8*)(lds + PG8_SA(b, h) + aoff + m * 2048 + k * 1024); } while (0)
#define PG8_LDB(dst, b, h) do { _Pragma("unroll") for (int n = 0; n < 2; ++n) _Pragma("unroll") for (int k = 0; k < 2; ++k) dst[n][k] = *(const PG8_LAS bf16x8*)(lds + PG8_SB(b, h) + boff + n * 2048 + k * 1024); } while (0)
#define PG8_MMA(ai, bj, At, Bt) do { __builtin_amdgcn_s_setprio(1); _Pragma("unroll") for (int m = 0; m < 4; ++m) _Pragma("unroll") for (int n = 0; n < 2; ++n) _Pragma("unroll") for (int k = 0; k < 2; ++k) \
        acc[ai][bj][m][n] = __builtin_amdgcn_mfma_f32_16x16x32_bf16(Bt[n][k], At[m][k], acc[ai][bj][m][n], 0, 0, 0); __builtin_amdgcn_s_setprio(0); } while (0)
#define PG8_WAIT_V(n) asm volatile("s_waitcnt vmcnt(" #n ")" ::: "memory")
#define PG8_WAIT_L(n) asm volatile("s_waitcnt lgkmcnt(" #n ")" ::: "memory")
#define PG8_BAR __builtin_amdgcn_s_barrier()
#define PG8_SCHED __builtin_amdgcn_sched_barrier(0)
    Unit cur, nxt; int ui = 0;
    if (!S.next(0, cur)) return;
    f32x4 acc[2][2][4][2];
#pragma unroll
    for (int a = 0; a < 2; ++a)
#pragma unroll
        for (int b = 0; b < 2; ++b)
#pragma unroll
            for (int m = 0; m < 4; ++m)
#pragma unroll
                for (int n = 0; n < 2; ++n) acc[a][b][m][n] = (f32x4){0.f, 0.f, 0.f, 0.f};
    bf16x8 At[4][2], B0[2][2], B1[2][2];
    const char* cA = (const char*)g.A + (size_t)cur.pm * tstep + cur.ko; const char* cB = (const char*)g.Bt + (size_t)cur.pn * tstep + cur.ko;
    S.a_ready(cur);
    if constexpr (SP2) {
        PG8_STAGE(PG8_SB(0, 0), cB, voffB); PG8_STAGE(PG8_SB(0, 1), cB + hstep, voffB); PG8_STAGE(PG8_SA(0, 0), cA, voffA); PG8_STAGE(PG8_SA(0, 1), cA + hstep, voffA);
        if (wr == 1) PG8_BAR;
        PG8_WAIT_V(2); PG8_BAR;
        PG8_STAGE(PG8_SB(1, 0), cB + kstep, voffB); PG8_STAGE(PG8_SA(1, 0), cA + kstep, voffA); PG8_STAGE(PG8_SB(1, 1), cB + hstep + kstep, voffB);
        PG8_WAIT_V(6); PG8_BAR;
    } else {
        PG8_STAGE(PG8_SB(0, 0), cB, voffB); PG8_STAGE(PG8_SA(0, 0), cA, voffA); PG8_STAGE(PG8_SB(0, 1), cB + hstep, voffB); PG8_STAGE(PG8_SA(0, 1), cA + hstep, voffA);
        if (wr == 1) PG8_BAR;
        PG8_WAIT_V(4); PG8_BAR;
        PG8_STAGE(PG8_SB(1, 0), cB + kstep, voffB); PG8_STAGE(PG8_SA(1, 0), cA + kstep, voffA); PG8_STAGE(PG8_SB(1, 1), cB + hstep + kstep, voffB);
        PG8_WAIT_V(6); PG8_BAR;
    }
    for (;;) {
        const bool has_next = S.next(ui + 1, nxt);
        const char* nA = has_next ? (const char*)g.A + (size_t)nxt.pm * tstep + nxt.ko : cA; const char* nB = has_next ? (const char*)g.Bt + (size_t)nxt.pn * tstep + nxt.ko : cB;
        for (int t = 0; t < nt; t += 2) {
            const bool last = (t == nt - 2);
            const char* a1 = cA + (size_t)(t + 1) * kstep;
            const char* a2 = last ? nA : cA + (size_t)(t + 2) * kstep; const char* b2 = last ? nB : cB + (size_t)(t + 2) * kstep;
            const char* a3 = a2 + kstep; const char* b3 = b2 + kstep;
            if (last && has_next) S.a_ready(nxt);
            if constexpr (SP2) {
            PG8_LDB(B0, 0, 0); PG8_LDB(B1, 0, 1); PG8_SCHED; PG8_LDA(At, 0, 0); PG8_STAGE(PG8_SA(1, 1), a1 + hstep, voffA);
            PG8_WAIT_V(8); PG8_WAIT_L(0); PG8_BAR; PG8_MMA(0, 0, At, B0); PG8_MMA(0, 1, At, B1); PG8_BAR; PG8_SCHED;
            PG8_LDA(At, 0, 1); PG8_STAGE(PG8_SB(0, 0), b2, voffB); PG8_STAGE(PG8_SB(0, 1), b2 + hstep, voffB); PG8_STAGE(PG8_SA(0, 0), a2, voffA);
            PG8_WAIT_V(8); PG8_WAIT_L(0); PG8_BAR; PG8_MMA(1, 0, At, B0); PG8_MMA(1, 1, At, B1); PG8_BAR; PG8_SCHED;
            PG8_LDB(B0, 1, 0); PG8_LDB(B1, 1, 1); PG8_SCHED; PG8_LDA(At, 1, 0); PG8_STAGE(PG8_SA(0, 1), a2 + hstep, voffA);
            PG8_WAIT_V(8); PG8_WAIT_L(0); PG8_BAR; PG8_MMA(0, 0, At, B0); PG8_MMA(0, 1, At, B1); PG8_BAR; PG8_SCHED;
            PG8_LDA(At, 1, 1); PG8_STAGE(PG8_SB(1, 0), b3, voffB); PG8_STAGE(PG8_SB(1, 1), b3 + hstep, voffB); PG8_STAGE(PG8_SA(1, 0), a3, voffA);
            PG8_WAIT_V(8); PG8_WAIT_L(0); PG8_BAR; PG8_MMA(1, 0, At, B0); PG8_MMA(1, 1, At, B1); PG8_BAR; PG8_SCHED;
            } else {
            PG8_LDB(B0, 0, 0); PG8_SCHED; PG8_LDA(At, 0, 0); PG8_STAGE(PG8_SA(1, 1), a1 + hstep, voffA);
            PG8_WAIT_L(8); PG8_BAR; PG8_WAIT_L(0); PG8_MMA(0, 0, At, B0); PG8_BAR; PG8_SCHED;
            PG8_LDB(B1, 0, 1); PG8_STAGE(PG8_SB(0, 0), b2, voffB);
            PG8_BAR; PG8_WAIT_L(0); PG8_MMA(0, 1, At, B1); PG8_BAR;
            PG8_LDA(At, 0, 1); PG8_STAGE(PG8_SA(0, 0), a2, voffA);
            PG8_BAR; PG8_WAIT_L(0); PG8_MMA(1, 0, At, B0); PG8_BAR; PG8_SCHED;
            PG8_STAGE(PG8_SB(0, 1), b2 + hstep, voffB);
            PG8_WAIT_V(6); PG8_BAR; PG8_MMA(1, 1, At, B1); PG8_BAR;
            PG8_LDB(B0, 1, 0); PG8_SCHED; PG8_LDA(At, 1, 0); PG8_STAGE(PG8_SA(0, 1), a2 + hstep, voffA);
            PG8_WAIT_L(8); PG8_BAR; PG8_WAIT_L(0); PG8_MMA(0, 0, At, B0); PG8_BAR; PG8_SCHED;
            PG8_LDB(B1, 1, 1); PG8_STAGE(PG8_SB(1, 0), b3, voffB);
            PG8_BAR; PG8_WAIT_L(0); PG8_MMA(0, 1, At, B1); PG8_BAR;
            PG8_LDA(At, 1, 1); PG8_STAGE(PG8_SA(1, 0), a3, voffA);
            PG8_BAR; PG8_WAIT_L(0); PG8_MMA(1, 0, At, B0); PG8_BAR; PG8_SCHED;
            PG8_STAGE(PG8_SB(1, 1), b3 + hstep, voffB);
            PG8_WAIT_V(6); PG8_BAR; PG8_MMA(1, 1, At, B1); PG8_BAR;
            }
        }
        if constexpr (ALIGN_EPI) { if (wr == 0) PG8_BAR; }
        if constexpr (!Epi::AFTER_DRAIN) { E(acc, cur, wr, wc, fr, fq); S.done(cur); }
        if (!has_next) break;
#pragma unroll
        for (int a = 0; a < 2; ++a)
#pragma unroll
            for (int b = 0; b < 2; ++b)
#pragma unroll
                for (int m = 0; m < 4; ++m)
#pragma unroll
                    for (int n = 0; n < 2; ++n) acc[a][b][m][n] = (f32x4){0.f, 0.f, 0.f, 0.f};
        cur = nxt; cA = nA; cB = nB; ++ui;
        if constexpr (ALIGN_EPI) { if (wr == 1) PG8_BAR; }
    }
    PG8_WAIT_V(0);
    if constexpr (!ALIGN_EPI) { if (wr == 0) PG8_BAR; }
    PG8_BAR;
    if constexpr (Epi::AFTER_DRAIN) { E.fused(acc, cur, wr, wc, fr, fq, lds, wid, lane); S.done(cur); }
#undef PG8_SA
#undef PG8_SB
#undef PG8_STAGE
#undef PG8_LDA
#undef PG8_LDB
#undef PG8_MMA
#undef PG8_WAIT_V
#undef PG8_WAIT_L
#undef PG8_BAR
#undef PG8_SCHED
}
}

#define LAS __attribute__((address_space(3)))
typedef unsigned short bf16_t;
typedef short bf16x8 __attribute__((ext_vector_type(8)));
typedef short s16x4 __attribute__((ext_vector_type(4)));
typedef float f32x4 __attribute__((ext_vector_type(4)));
typedef float f32x2 __attribute__((ext_vector_type(2)));
typedef float f32x16 __attribute__((ext_vector_type(16)));
typedef unsigned u32x4 __attribute__((ext_vector_type(4)));
typedef unsigned u32x2 __attribute__((ext_vector_type(2)));
using pg8::cvt_pk_bf16; using pg8::TOK_P; using pg8::TOK_ALL; using pg8::LOG2E;

constexpr int MP = 16640;
constexpr int LROWS = 33280;
constexpr int SEQS = 2112;
constexpr float EPS = 1e-6f;
constexpr size_t al256(size_t x) { return (x + 255) & ~(size_t)255; }
constexpr size_t WS_CTL = 0;
constexpr size_t CTL_BYTES = 131072;
constexpr int CW_RS = 16384;
constexpr size_t WS_ROPEDF = 1u << 20;
constexpr size_t WS_ROPEMLA = WS_ROPEDF + 4096 * 16 * 4;
constexpr size_t WS_W0 = 2u << 20;
constexpr size_t SZ_GU = (size_t)5632 * 1024 * 2, SZ_DN = (size_t)1024 * 2816 * 2, SZ_SQ = (size_t)1024 * 1024 * 2, SZ_PLEI = (size_t)1024 * 256 * 2;
constexpr size_t WS_GU = WS_W0;
constexpr size_t WS_DN = WS_GU + 4 * SZ_GU;
constexpr size_t WS_PLEG = WS_DN + 4 * SZ_DN;
constexpr size_t WS_PLEI = WS_PLEG + 2 * SZ_SQ;
constexpr size_t WS_ABIN = WS_PLEI + 2 * SZ_PLEI;
constexpr size_t WS_ABOUT = WS_ABIN + (size_t)3072 * 1024 * 2;
constexpr size_t WS_MLAIN = WS_ABOUT + SZ_SQ;
constexpr size_t WS_UQ = WS_MLAIN + (size_t)768 * 1024 * 2;
constexpr size_t WS_UKV = WS_UQ + (size_t)1536 * 384 * 2;
constexpr size_t WS_MLAOUT = WS_UKV + (size_t)2048 * 256 * 2;
constexpr size_t WS_A = al256(WS_MLAOUT + SZ_SQ);
constexpr size_t WS_PB = WS_A + (size_t)MP * 1024 * 2;
constexpr size_t WS_LAT = WS_PB + (size_t)2 * MP * 256 * 2;
constexpr size_t WS_KR = WS_LAT + (size_t)LROWS * 256 * 2;
constexpr size_t WS_CQ = WS_KR + (size_t)LROWS * 32 * 2;
constexpr size_t WS_BIG = al256(WS_CQ + (size_t)MP * 384 * 2);
constexpr size_t SZ_ACT = (size_t)MP * 2816 * 2, SZ_F = (size_t)MP * 1024 * 4, SZ_SKV1 = (size_t)8 * SEQS * 512 * 2, SZ_KVP1 = (size_t)16384 * 512 * 2;
constexpr size_t WS_ACT = WS_BIG;
constexpr size_t WS_F = WS_BIG + SZ_ACT;
constexpr size_t WS_SKV = WS_F + SZ_F;
constexpr size_t WS_PART = WS_SKV + 4 * SZ_SKV1;
constexpr size_t WS_PIN = WS_PART + (size_t)11 * 256 * 1024 * 4;
constexpr size_t WS_XB = WS_PIN + (size_t)256 * 1024 * 4;
constexpr size_t WS_END = WS_XB + (size_t)2 * 16384 * 4 * 4;
constexpr size_t WS_Q0 = WS_BIG;
constexpr size_t WS_KVP = WS_Q0 + (size_t)2 * MP * 512 * 2;
constexpr size_t WS_DFO = al256(WS_KVP + 4 * SZ_KVP1);
static_assert(WS_DFO + (size_t)2 * MP * 512 * 2 <= WS_SKV, "layer-0 overlay");
constexpr size_t WS_MI = WS_F;
constexpr size_t WS_Q96 = WS_BIG;
constexpr size_t WS_KN = WS_Q96 + (size_t)MP * 1536 * 2;
constexpr size_t WS_VV = WS_KN + (size_t)LROWS * 1024 * 2;
static_assert(WS_VV + (size_t)LROWS * 1024 * 2 <= WS_PART, "layer-1 overlay");
static_assert((size_t)MP * 768 * 4 <= SZ_F, "MI fits F");
constexpr long OUT_SBK_P = 16908288, OUT_LAT_P = 50462720, OUT_KR_P = 54657024, OUT_SBK_S = 55181312, OUT_LAT_S = 55443456, OUT_KR_S = 55476224, OUT_TOTAL = 55480320;

constexpr int LDS_BYTES = 135168;
constexpr int LDS_MISC = 131072;

struct Args { const float* in[28]; float* out; unsigned char* ws; };
__device__ const float INV_DF[8] = {1.0f, 0.193922743f, 0.0376060307f, 0.00729266461f, 0.00141421356f, 0.000274248188f, 5.3182961e-05f, 1.03133862e-05f};
__device__ const float INV_MLA[16] = {1.0f, 0.562341332f, 0.316227764f, 0.177827939f, 0.100000001f, 0.0562341325f, 0.0316227749f, 0.0177827943f, 0.00999999978f, 0.00562341325f, 0.00316227763f, 0.00177827943f, 0.00100000005f, 0.000562341302f, 0.000316227757f, 0.00017782794f};

__device__ __forceinline__ float wave_sum(float v) {
    v += shx<1>(v); v += shx<2>(v); v += shx<4>(v); v += shx<8>(v); v += shx<16>(v);
    return __builtin_bit_cast(float, __builtin_amdgcn_readlane(__builtin_bit_cast(int, v), 0)) + __builtin_bit_cast(float, __builtin_amdgcn_readlane(__builtin_bit_cast(int, v), 32));
}
__device__ __forceinline__ unsigned pk2(float lo, float hi) { return cvt_pk_bf16(lo, hi); }

template <int MAP> __device__ __forceinline__ int wsrc(int v, int N) {
    if (MAP == 1) { const int q8 = v >> 3, r8 = v & 7; return r8 < 4 ? 4 * q8 + r8 : 2816 + 4 * q8 + (r8 - 4); }
    return v < N ? v : -1;
}
template <int MAP> __device__ __forceinline__ void transpose_item(const float* W, int K, int N, int Nv, bf16_t* WT, LAS float* scr, int item, int lane) {
    const int nblk = Nv / 32, kb = item / nblk, nb = item % nblk, k0 = 64 * kb, n0 = 32 * nb;
    const int c4 = lane & 7, kr = lane >> 3;
    const int sc = wsrc<MAP>(n0 + 4 * c4, N);
    f32x4 v[8];
#pragma unroll
    for (int i = 0; i < 8; ++i) v[i] = sc >= 0 ? *(const f32x4*)(W + (size_t)(k0 + 8 * i + kr) * N + sc) : (f32x4){0.f, 0.f, 0.f, 0.f};
#pragma unroll
    for (int i = 0; i < 8; ++i) { LAS float* d = scr + (8 * i + kr) * 33 + 4 * c4; d[0] = v[i][0]; d[1] = v[i][1]; d[2] = v[i][2]; d[3] = v[i][3]; }
    asm volatile("s_waitcnt lgkmcnt(0)" ::: "memory");
    const int c = lane & 7;
#pragma unroll
    for (int j = 0; j < 4; ++j) { const int n = (lane >> 3) + 8 * j; const LAS float* s = scr + (8 * c) * 33 + n;
        u32x4 o; o.x = pk2(s[0 * 33], s[1 * 33]); o.y = pk2(s[2 * 33], s[3 * 33]); o.z = pk2(s[4 * 33], s[5 * 33]); o.w = pk2(s[6 * 33], s[7 * 33]);
        *(u32x4*)(WT + (size_t)(n0 + n) * K + k0 + 8 * c) = o; }
    asm volatile("s_waitcnt lgkmcnt(0)" ::: "memory");
}
__device__ __forceinline__ void cvt_rows(const float* src, bf16_t* dst, int nrows, int width, int spr, int dpr, long gt, long ngt) {
    const int w4 = width >> 2; const long total = (long)nrows * w4;
    constexpr int U = 16;
    for (long q0 = gt; q0 < total; q0 += ngt * U) {
        f32x4 v[U];
#pragma unroll
        for (int u = 0; u < U; ++u) { const long q = q0 + ngt * u; if (q < total) { const int r = (int)(q / w4), c4 = (int)(q % w4); v[u] = __builtin_nontemporal_load((const f32x4*)(src + (size_t)r * width + 4 * c4)); } }
#pragma unroll
        for (int u = 0; u < U; ++u) { const long q = q0 + ngt * u; if (q < total) { const int r = (int)(q / w4), c4 = (int)(q % w4);
            const size_t dr = (size_t)(r / spr) * dpr + (r % spr);
            u32x2 w; w.x = pk2(v[u][0], v[u][1]); w.y = pk2(v[u][2], v[u][3]); *(u32x2*)(dst + dr * width + 4 * c4) = w; } }
    }
}
__device__ __forceinline__ void zero_segs(bf16_t* base, int nseq, size_t stride, int nel, long gt, long ngt) {
    const int n8 = nel >> 3; const long total = (long)nseq * n8;
    for (long q = gt; q < total; q += ngt) { const int s = (int)(q / n8), c = (int)(q % n8); *(u32x4*)(base + (size_t)s * stride + 8 * c) = (u32x4){0u, 0u, 0u, 0u}; }
}
__device__ __forceinline__ void sincos_tab(float ang, float& c, float& s) {
    double rev = (double)ang * 0.15915494309189535; rev -= floor(rev);
    const float rf = (float)rev; c = __builtin_amdgcn_cosf(rf); s = __builtin_amdgcn_sinf(rf);
}

template <bool FIRST, bool HASF, bool HASB, int KSUM = 0, bool GATE = false>
__device__ __forceinline__ void row_phase(const float* xp, const float* xs, float* X, const float* F, const float* ga, float coef, const float* gb, bf16_t* A, const float* part = nullptr, const float* pin = nullptr, int row_first = 0) {
    int t_ = threadIdx.x; asm volatile("" : "+v"(t_));
    const int lane = t_ & 63, gw = blockIdx.x * 8 + __builtin_amdgcn_readfirstlane(t_ >> 6), ngw = gridDim.x * 8;
    for (int row = row_first + gw; row < TOK_ALL; row += ngw) {
        const float* xr = FIRST ? (row < TOK_P ? xp + (size_t)row * 1024 : xs + (size_t)(row - TOK_P) * 1024) : X + (size_t)row * 1024;
        f32x4 x[4];
#pragma unroll
        for (int j = 0; j < 4; ++j) x[j] = ((const f32x4*)xr)[lane + 64 * j];
        if (HASF) {
            f32x4 f[4]; float ss = 0.f;
#pragma unroll
            for (int j = 0; j < 4; ++j) {
                if (KSUM > 0 && row >= TOK_P) {
                    f32x4 s = ((const f32x4*)(part + (size_t)(row - TOK_P) * 1024))[lane + 64 * j];
#pragma unroll
                    for (int k = 1; k < KSUM; ++k) s = s + ((const f32x4*)(part + ((size_t)k * 256 + (row - TOK_P)) * 1024))[lane + 64 * j];
                    if (GATE) { const f32x4 p = ((const f32x4*)(pin + (size_t)(row - TOK_P) * 1024))[lane + 64 * j];
#pragma unroll
                        for (int q = 0; q < 4; ++q) s[q] = p[q] * __builtin_amdgcn_rcpf(1.0f + __builtin_amdgcn_exp2f(-s[q] * LOG2E)); }
                    f[j] = s;
                } else f[j] = ((const f32x4*)(F + (size_t)row * 1024))[lane + 64 * j];
                ss += (f[j][0] * f[j][0] + f[j][1] * f[j][1]) + (f[j][2] * f[j][2] + f[j][3] * f[j][3]); }
            const float r = coef / sqrtf(wave_sum(ss) * (1.f / 1024.f) + EPS);
#pragma unroll
            for (int j = 0; j < 4; ++j) { const f32x4 g = ((const f32x4*)ga)[lane + 64 * j]; x[j] = x[j] + f[j] * g * r; ((f32x4*)(X + (size_t)row * 1024))[lane + 64 * j] = x[j]; }
        }
        if (HASB) {
            float ss = 0.f;
#pragma unroll
            for (int j = 0; j < 4; ++j) ss += (x[j][0] * x[j][0] + x[j][1] * x[j][1]) + (x[j][2] * x[j][2] + x[j][3] * x[j][3]);
            const float r = 1.0f / sqrtf(wave_sum(ss) * (1.f / 1024.f) + EPS);
#pragma unroll
            for (int j = 0; j < 4; ++j) { const f32x4 g = ((const f32x4*)gb)[lane + 64 * j]; const f32x4 y = x[j] * g * r;
                u32x2 w; w.x = pk2(y[0], y[1]); w.y = pk2(y[2], y[3]); ((u32x2*)(A + (size_t)row * 1024))[lane + 64 * j] = w; }
        }
    }
}
__device__ __forceinline__ void mla_row_phase(const float* MI, const float* qn, const float* kvn, const float* rope, bf16_t* CQ, bf16_t* LAT, bf16_t* KR, float* out) {
    int t_ = threadIdx.x; asm volatile("" : "+v"(t_));
    const int lane = t_ & 63, gw = blockIdx.x * 8 + __builtin_amdgcn_readfirstlane(t_ >> 6), ngw = gridDim.x * 8;
    for (int row = gw; row < TOK_ALL; row += ngw) {
        const float* mi = MI + (size_t)row * 768;
        const int lrow = row < TOK_P ? row : TOK_P + ((row - TOK_P) >> 4) * SEQS + 2048 + ((row - TOK_P) & 15);
        {   const f32x4 a = ((const f32x4*)mi)[lane]; const f32x2 b = ((const f32x2*)(mi + 256))[lane];
            const float ss = wave_sum((a[0] * a[0] + a[1] * a[1]) + (a[2] * a[2] + a[3] * a[3]) + (b[0] * b[0] + b[1] * b[1]));
            const float r = 1.0f / sqrtf(ss * (1.f / 384.f) + EPS);
            const f32x4 g = ((const f32x4*)qn)[lane]; const f32x2 g2 = ((const f32x2*)(qn + 256))[lane];
            u32x2 w; w.x = pk2(a[0] * r * g[0], a[1] * r * g[1]); w.y = pk2(a[2] * r * g[2], a[3] * r * g[3]);
            ((u32x2*)(CQ + (size_t)row * 384))[lane] = w; ((unsigned*)(CQ + (size_t)row * 384 + 256))[lane] = pk2(b[0] * r * g2[0], b[1] * r * g2[1]); }
        {   const f32x4 a = ((const f32x4*)(mi + 384))[lane];
            const float ss = wave_sum((a[0] * a[0] + a[1] * a[1]) + (a[2] * a[2] + a[3] * a[3]));
            const float r = 1.0f / sqrtf(ss * (1.f / 256.f) + EPS);
            const f32x4 g = ((const f32x4*)kvn)[lane]; const f32x4 y = a * g * r;
            float* op = row < TOK_P ? out + OUT_LAT_P + (size_t)row * 256 : out + OUT_LAT_S + (size_t)(row - TOK_P) * 256;
            __builtin_nontemporal_store(y, (f32x4*)op + lane);
            u32x2 w; w.x = pk2(y[0], y[1]); w.y = pk2(y[2], y[3]); ((u32x2*)(LAT + (size_t)lrow * 256))[lane] = w; }
        {   const int i = lane & 31; const float v = mi[640 + i]; const float oth = shx<16>(v);
            const int pos = pg8::tok_pos(row); const float c = rope[pos * 32 + (i & 15)], s = rope[pos * 32 + 16 + (i & 15)];
            const float y = (i < 16) ? v * c - oth * s : v * c + oth * s;
            const float yn = shx<1>(y);
            if (lane < 32) { float* op = row < TOK_P ? out + OUT_KR_P + (size_t)row * 32 : out + OUT_KR_S + (size_t)(row - TOK_P) * 32; op[i] = y;
                if ((lane & 1) == 0) ((unsigned*)(KR + (size_t)lrow * 32))[lane >> 1] = pk2(y, yn); } }
    }
}

__device__ __forceinline__ int crow(int r, int hi) { return (r & 3) + 8 * (r >> 2) + 4 * hi; }
__device__ __forceinline__ bf16x8 pack8(const f32x16& p, int b) {
    u32x4 w; w.x = pk2(p[b], p[b + 1]); w.y = pk2(p[b + 2], p[b + 3]); w.z = pk2(p[b + 4], p[b + 5]); w.w = pk2(p[b + 6], p[b + 7]); return __builtin_bit_cast(bf16x8, w);
}
__device__ __forceinline__ s16x4 vtr(const LAS unsigned char* p) { return __builtin_bit_cast(s16x4, __builtin_amdgcn_ds_read_tr16_b64_v4i16((LAS s16x4*)p)); }

template <int DQK, int DV, int MODE, int NCOMP>
__device__ __forceinline__ void attn_unit(LAS unsigned char* lds, const bf16_t* Qp, int ldq, const bf16_t* Kp, int ldk, const bf16_t* K2p, const bf16_t* Vp, int ldv,
                                          bf16_t* Op, int ldo, int nq, int qpos0, int ntiles, int kvalid, float lam, const float* subln) {
    constexpr int RSK = DQK * 2 + 16, RSV = DV * 2 + 64, KOFF = 0, VOFF = 16384, BUFB = 36864  , NS = DQK / 16, ND = DV / 32;
    constexpr int KC = DQK / 8, VC = DV / 8;
    constexpr int NKP = (64 * KC + 511) / 512, NVP = (64 * VC) / 512;
    int tid = threadIdx.x; asm volatile("" : "+v"(tid));
    const int lane = tid & 63, wid = __builtin_amdgcn_readfirstlane(tid >> 6), r32 = lane & 31, hi = lane >> 5;
    const int wq0 = 32 * wid; const bool wactive = wq0 < nq;
    const int qrow = (wq0 + r32 < nq) ? wq0 + r32 : nq - 1;
    const int qpos = qpos0 + wq0 + r32;
    const int cw = wactive ? ((qpos0 + wq0) >> 6) : -1;
    f32x16 osave[ND];
#pragma unroll
    for (int comp = 0; comp < NCOMP; ++comp) {
        bf16x8 qf[NS];
#pragma unroll
        for (int s = 0; s < NS; ++s) qf[s] = *(const bf16x8*)(Qp + (size_t)qrow * ldq + comp * 64 + 16 * s + 8 * hi);
        if (DQK == 96) {
            const float* rp = subln + (size_t)(qpos0 + qrow) * 32 + 8 * hi;
            u32x4 wa, wb;
#pragma unroll
            for (int j2 = 0; j2 < 4; ++j2) { float ra[2], rb[2];
#pragma unroll
                for (int jj = 0; jj < 2; ++jj) { const int j = 2 * j2 + jj;
                    const float x1 = __builtin_bit_cast(float, (unsigned)(unsigned short)qf[NS - 2][j] << 16), x2 = __builtin_bit_cast(float, (unsigned)(unsigned short)qf[NS - 1][j] << 16);
                    const float c = rp[j], s = rp[16 + j]; ra[jj] = x1 * c - x2 * s; rb[jj] = x2 * c + x1 * s; }
                wa[j2] = pk2(ra[0], ra[1]); wb[j2] = pk2(rb[0], rb[1]); }
            qf[NS - 2] = __builtin_bit_cast(bf16x8, wa); qf[NS - 1] = __builtin_bit_cast(bf16x8, wb);
        }
        f32x16 o[ND];
#pragma unroll
        for (int d = 0; d < ND; ++d)
#pragma unroll
            for (int r = 0; r < 16; ++r) o[d][r] = 0.f;
        float m_run = -INFINITY, l_run = 0.f, c_run = 0.f;
        u32x4 kreg[NKP], vreg[NVP];
#define ATT_ISSUE(tile_) do { const int tl_ = (tile_); \
            _Pragma("unroll") for (int i = 0; i < NKP; ++i) { const int pi = tid + 512 * i; if (pi < 64 * KC) { const int key = pi / KC, c = pi % KC; const size_t krow = (size_t)tl_ * 64 + key; \
                    const bf16_t* src = (DQK == 96 && c >= 8) ? K2p + krow * 32 + (c - 8) * 8 : Kp + krow * ldk + comp * 64 + c * 8; \
                    kreg[i] = *(const u32x4*)src; } } \
            _Pragma("unroll") for (int i = 0; i < NVP; ++i) { const int pi = tid + 512 * i; const int key = pi / VC, c = pi % VC; vreg[i] = *(const u32x4*)(Vp + ((size_t)tl_ * 64 + key) * ldv + c * 8); } \
        } while (0)
#define ATT_WRITE(boff_) do { \
            _Pragma("unroll") for (int i = 0; i < NKP; ++i) { const int pi = tid + 512 * i; if (pi < 64 * KC) { const int key = pi / KC, c = pi % KC; *(LAS u32x4*)(lds + (boff_) + KOFF + key * RSK + c * 16) = kreg[i]; } } \
            _Pragma("unroll") for (int i = 0; i < NVP; ++i) { const int pi = tid + 512 * i; const int key = pi / VC, c = pi % VC; *(LAS u32x4*)(lds + (boff_) + VOFF + key * RSV + c * 16) = vreg[i]; } \
        } while (0)
        volatile LAS int* dflag = (volatile LAS int*)(lds + LDS_MISC + 128);
        bool wdone = !wactive;
        ATT_ISSUE(MODE == 1 ? ntiles - 1 : 0);
        ATT_WRITE(0);
        if (ntiles > 1) ATT_ISSUE(MODE == 1 ? ntiles - 2 : 1);
        __syncthreads();
        for (int it = 0; it < ntiles; ++it) {
            const int tile = MODE == 1 ? ntiles - 1 - it : it;
            const int boff = (it & 1) * BUFB;
            if (it + 1 < ntiles) { ATT_WRITE(BUFB - boff); if (it + 2 < ntiles) ATT_ISSUE(MODE == 1 ? tile - 2 : tile + 2); }
            if (tile <= cw) {
                f32x16 p0, p1;
#pragma unroll
                for (int r = 0; r < 16; ++r) { p0[r] = 0.f; p1[r] = 0.f; }
                const LAS unsigned char* kb = lds + boff + KOFF + r32 * RSK + hi * 16;
#pragma unroll
                for (int s = 0; s < NS; ++s) {
                    const bf16x8 a0 = *(const LAS bf16x8*)(kb + s * 32), a1 = *(const LAS bf16x8*)(kb + 32 * RSK + s * 32);
                    p0 = __builtin_amdgcn_mfma_f32_32x32x16_bf16(a0, qf[s], p0, 0, 0, 0);
                    p1 = __builtin_amdgcn_mfma_f32_32x32x16_bf16(a1, qf[s], p1, 0, 0, 0);
                }
                if (MODE == 0) {
                    if (__builtin_expect(tile * 64 + 64 > kvalid, 0)) {
                        asm volatile("" ::: "memory");
#pragma unroll
                        for (int r = 0; r < 16; ++r) { const int kp = tile * 64 + crow(r, hi); if (kp >= kvalid) p0[r] = -INFINITY; if (kp + 32 >= kvalid) p1[r] = -INFINITY; }
                        asm volatile("" : "+v"(p0), "+v"(p1));
                    }
                    float mx = __builtin_fmaxf(__builtin_fmaxf(p0[0], p1[0]), p0[1]);
#pragma unroll
                    for (int r = 1; r < 15; ++r) mx = __builtin_fmaxf(__builtin_fmaxf(mx, p1[r]), p0[r + 1]);
                    mx = __builtin_fmaxf(mx, p1[15]);
                    mx = max32(mx, lane);
                    const float mn = fmaxf(m_run, mx), alpha = __builtin_amdgcn_exp2f(m_run - mn); m_run = mn;
                    {   const f32x2 mn2 = {mn, mn};
#pragma unroll
                        for (int r = 0; r < 16; r += 2) { f32x2 t0 = {p0[r], p0[r + 1]}, t1 = {p1[r], p1[r + 1]}; t0 = t0 - mn2; t1 = t1 - mn2;
                            asm volatile("" : "+v"(t0), "+v"(t1));
                            p0[r] = __builtin_amdgcn_exp2f(t0[0]); p0[r + 1] = __builtin_amdgcn_exp2f(t0[1]); p1[r] = __builtin_amdgcn_exp2f(t1[0]); p1[r + 1] = __builtin_amdgcn_exp2f(t1[1]); } }
                    const f32x16 ps = p0 + p1;
                    const float ls = ((ps[0] + ps[1]) + (ps[2] + ps[3])) + ((ps[4] + ps[5]) + (ps[6] + ps[7])) + (((ps[8] + ps[9]) + (ps[10] + ps[11])) + ((ps[12] + ps[13]) + (ps[14] + ps[15])));
                    l_run = l_run * alpha + ls;
#pragma unroll
                    for (int d = 0; d < ND; ++d) o[d] = o[d] * alpha;
                } else {
                    f32x16 lf0, lf1; float gs[2][4];
#pragma unroll
                    for (int r = 0; r < 16; ++r) {
                        const int kp = tile * 64 + crow(r, hi);
                        const float z0 = p0[r], z1 = p1[r];
                        const float s0 = fmaxf(z0, 0.f) + __builtin_amdgcn_logf(1.0f + __builtin_amdgcn_exp2f(-fabsf(z0)));
                        const float s1 = fmaxf(z1, 0.f) + __builtin_amdgcn_logf(1.0f + __builtin_amdgcn_exp2f(-fabsf(z1)));
                        lf0[r] = (kp < qpos) ? -s0 : 0.f; lf1[r] = (kp + 32 < qpos) ? -s1 : 0.f;
                    }
#pragma unroll
                    for (int g = 0; g < 4; ++g) { gs[0][g] = (lf0[4 * g] + lf0[4 * g + 1]) + (lf0[4 * g + 2] + lf0[4 * g + 3]); gs[1][g] = (lf1[4 * g] + lf1[4 * g + 1]) + (lf1[4 * g + 2] + lf1[4 * g + 3]); }
                    float running = c_run;
#pragma unroll
                    for (int kh = 1; kh >= 0; --kh)
#pragma unroll
                        for (int g = 3; g >= 0; --g) {
                            const float pg = shx32(gs[kh][g], lane);
                            float b = running + (hi ? 0.f : pg);
#pragma unroll
                            for (int e = 3; e >= 0; --e) {
                                const int r = 4 * g + e; const int kp = tile * 64 + 32 * kh + crow(r, hi);
                                const float z = kh ? p1[r] : p0[r], lfv = kh ? lf1[r] : lf0[r];
                                const float w = (kp < qpos) ? __builtin_amdgcn_exp2f(z + lfv + b) : 0.f;
                                b += lfv;
                                if (kh) p1[r] = w; else p0[r] = w;
                            }
                            running += gs[kh][g] + pg;
                        }
                    c_run = running;
                    wdone = (__builtin_amdgcn_ballot_w64(c_run > -160.f) == 0ull);
                }
                const bf16x8 pb0 = pack8(p0, 0), pb1 = pack8(p0, 8), pb2 = pack8(p1, 0), pb3 = pack8(p1, 8);
                const LAS unsigned char* vb = lds + boff + VOFF + (4 * hi + ((lane & 15) >> 2)) * RSV + ((lane >> 4) & 1) * 32 + (lane & 3) * 8;
#pragma unroll
                for (int d = 0; d < ND; ++d) {
#pragma unroll
                    for (int ks = 0; ks < 4; ++ks) {
                        const s16x4 lo = vtr(vb + (16 * ks) * RSV + d * 64), hh = vtr(vb + (16 * ks + 8) * RSV + d * 64);
                        const bf16x8 vf = (bf16x8){lo[0], lo[1], lo[2], lo[3], hh[0], hh[1], hh[2], hh[3]};
                        const bf16x8 pb = ks == 0 ? pb0 : ks == 1 ? pb1 : ks == 2 ? pb2 : pb3;
                        o[d] = __builtin_amdgcn_mfma_f32_32x32x16_bf16(vf, pb, o[d], 0, 0, 0);
                    }
                }
            }
            if (MODE == 1 && lane == 0) dflag[(it & 1) * 8 + wid] = wdone ? 1 : 0;
            __syncthreads();
            if (MODE == 1) { int all = 1;
#pragma unroll
                for (int w = 0; w < 8; ++w) all &= dflag[(it & 1) * 8 + w];
                if (all) break; }
        }
        if (MODE == 0) {
            const float lt = sum32(l_run, lane); const float inv = 1.0f / lt;
#pragma unroll
            for (int d = 0; d < ND; ++d)
#pragma unroll
                for (int r = 0; r < 16; ++r) o[d][r] *= inv;
        }
        if (NCOMP == 2 && comp == 0) {
#pragma unroll
            for (int d = 0; d < ND; ++d) osave[d] = o[d];
        } else {
            if (NCOMP == 2) {
                float ss = 0.f;
#pragma unroll
                for (int d = 0; d < ND; ++d)
#pragma unroll
                    for (int r = 0; r < 16; ++r) { o[d][r] = osave[d][r] - lam * o[d][r]; ss += o[d][r] * o[d][r]; }
                ss = sum32(ss, lane);
                const float rn = 0.8f / sqrtf(ss * (1.f / DV) + EPS);
#pragma unroll
                for (int d = 0; d < ND; ++d)
#pragma unroll
                    for (int g = 0; g < 4; ++g) { const f32x4 sg = *(const f32x4*)(subln + 32 * d + 8 * g + 4 * hi);
#pragma unroll
                        for (int e = 0; e < 4; ++e) o[d][4 * g + e] *= rn * sg[e]; }
            }
            if (wq0 + r32 < nq) {
                bf16_t* orow = Op + (size_t)(wq0 + r32) * ldo;
#pragma unroll
                for (int d = 0; d < ND; ++d)
#pragma unroll
                    for (int g = 0; g < 4; ++g) { u32x2 w; w.x = pk2(o[d][4 * g], o[d][4 * g + 1]); w.y = pk2(o[d][4 * g + 2], o[d][4 * g + 3]); *(u32x2*)(orow + 32 * d + 8 * g + 4 * hi) = w; }
            }
        }
    }
}

__device__ __forceinline__ int next_unit(unsigned* ctr, volatile LAS int* slot) {
    __syncthreads();
    if (threadIdx.x == 0) *slot = (int)atomicAdd(ctr, 1u);
    __syncthreads();
    return *slot;
}

template <class Epi> __device__ __forceinline__ void run_gemm(LAS unsigned char* lds, const bf16_t* A, const bf16_t* Bt, int M, int N, int K, const Epi& E) {
    pg8::Gemm g{A, Bt, M, N, K, K}; pg8::StaticOrder S; S.init(M, N, (int)gridDim.x, (int)blockIdx.x);
    pg8::gemm_phase<Epi, pg8::StaticOrder, true, true>(lds, g, S, E);
}
template <class Epi> __device__ __forceinline__ void run_gemm_fused(LAS unsigned char* lds, const bf16_t* A, const bf16_t* Bt, int K, const Epi& E) {
    pg8::Gemm g{A, Bt, TOK_P, 1024, K, K}; pg8::StaticOrder S; S.init(TOK_P, 1024, (int)gridDim.x, (int)blockIdx.x);
    pg8::gemm_phase<Epi, pg8::StaticOrder, false, true>(lds, g, S, E);
}
template <class Epi> __device__ __forceinline__ void run_gemm_split(LAS unsigned char* lds, const bf16_t* A, const bf16_t* Bt, int N, int K, int KS, const Epi& E) {
    pg8::Gemm g{A, Bt, 256, N, K / KS, K}; pg8::SplitOrder S; S.init(N, KS, TOK_P / 256, K / KS, (int)gridDim.x, (int)blockIdx.x);
    pg8::gemm_phase<Epi, pg8::SplitOrder, true, true>(lds, g, S, E);
}

#define OPQ() unsigned char* w_ = ws; asm volatile("" : "+s"(w_)); float* out_ = out; asm volatile("" : "+s"(out_))
#define ctl ((unsigned*)(w_ + WS_CTL))
#define ropedf ((float*)(w_ + WS_ROPEDF))
#define ropemla ((float*)(w_ + WS_ROPEMLA))
#define Abuf ((bf16_t*)(w_ + WS_A))
#define PB ((bf16_t*)(w_ + WS_PB))
#define LAT ((bf16_t*)(w_ + WS_LAT))
#define KR ((bf16_t*)(w_ + WS_KR))
#define CQ ((bf16_t*)(w_ + WS_CQ))
#define ACT ((bf16_t*)(w_ + WS_ACT))
#define F ((float*)(w_ + WS_F))
#define SKV ((bf16_t*)(w_ + WS_SKV))
#define Q0 ((bf16_t*)(w_ + WS_Q0))
#define KVP ((bf16_t*)(w_ + WS_KVP))
#define DFO ((bf16_t*)(w_ + WS_DFO))
#define MI ((float*)(w_ + WS_MI))
#define Q96 ((bf16_t*)(w_ + WS_Q96))
#define KN ((bf16_t*)(w_ + WS_KN))
#define VV ((bf16_t*)(w_ + WS_VV))
#define WSB(off) ((const bf16_t*)(w_ + (off)))
#define PART ((float*)(w_ + WS_PART))
#define PIN ((float*)(w_ + WS_PIN))
#define RSTAT(k_) pg8::RowStat{(unsigned*)(w_ + WS_XB + (size_t)(((k_) & 1) ^ 1) * 16384 * 16), (unsigned*)(w_ + WS_CTL) + CW_RS, 32u * (unsigned)(k_), 1.0f / 1024.0f, EPS}
#define XK(site_) ((l * 4 + (site_)) * 2 + 1)


constexpr int CW_BAR = 4096;
#define XB_TMO      128
#define XB_XCNT(j)  (256  + 64 * (j))
#define XB_XSUB(j)  (1280 + 64 * (j))
#define XB_XGEN(j)  (2304 + 64 * (j))
#define XB_TOP      3328
#define XB_TOPGEN   3392
#define XCD_BAR_WORDS 3456
#define XB_SPIN_CAP (1u << 18)

__device__ __forceinline__ unsigned xb_ld(unsigned* p)              { return __hip_atomic_load(p, __ATOMIC_RELAXED, __HIP_MEMORY_SCOPE_AGENT); }
__device__ __forceinline__ unsigned xb_add(unsigned* p, unsigned v) { return __hip_atomic_fetch_add(p, v, __ATOMIC_RELAXED, __HIP_MEMORY_SCOPE_AGENT); }
__device__ __forceinline__ unsigned xb_xcc_id() { return (unsigned)__builtin_amdgcn_s_getreg((3 << 11) | 20) & 0xFu; }
#define XB_SPIN(cond, bar) do { unsigned _sp = 0; while (cond) { __builtin_amdgcn_s_sleep(1); \
    if ((++_sp & 255u) == 0u) { if (xb_ld(&(bar)[XB_TMO])) break; if (_sp > XB_SPIN_CAP) { atomicAdd(&(bar)[XB_TMO], 1u); break; } } } } while (0)

struct XcdBarrier {
    unsigned* bar; unsigned x;
    volatile LAS unsigned* st;
};

__device__ __forceinline__ XcdBarrier xcd_barrier_post(unsigned* bar, volatile LAS unsigned* st) {
    XcdBarrier b; b.bar = bar; b.x = xb_xcc_id(); b.st = st;
    if (threadIdx.x == 0) (void)xb_add(&bar[XB_XCNT(b.x)], 1u);
    return b;
}
__device__ __forceinline__ void xcd_barrier_complete(unsigned* bar, unsigned x, unsigned& nloc, unsigned& nx) {
    const unsigned G = gridDim.x * gridDim.y * gridDim.z;
    unsigned sum, cnt, mine, sp = 0u;
    for (;;) {
        sum = 0u; cnt = 0u; mine = 0u;
#pragma unroll
        for (unsigned j = 0; j < 16; ++j) { const unsigned c = xb_ld(&bar[XB_XCNT(j)]); sum += c; cnt += (c > 0u) ? 1u : 0u; mine = (j == x) ? c : mine; }
        if (sum == G) break;
        __builtin_amdgcn_s_sleep(1);
        if ((++sp & 255u) == 0u) { if (xb_ld(&bar[XB_TMO])) break; if (sp > XB_SPIN_CAP) { atomicAdd(&bar[XB_TMO], 1u); break; } }
    }
    nloc = mine > 0u ? mine : 1u; nx = cnt > 0u ? cnt : 1u;
}

__device__ __forceinline__ void xcd_barrier(const XcdBarrier& b) {
    asm volatile("s_waitcnt vmcnt(0)" ::: "memory");
    __syncthreads();
    if (threadIdx.x == 0) {
        unsigned* bar = b.bar;
        __builtin_amdgcn_s_waitcnt(0);
        unsigned nloc = b.st[0], nx = b.st[1];
        if (nloc == 0u) { xcd_barrier_complete(bar, b.x, nloc, nx); b.st[0] = nloc; b.st[1] = nx; }
        const unsigned old = xb_add(&bar[XB_XSUB(b.x)], 1u);
        const unsigned gen = old / nloc;
        if (old + 1u == (gen + 1u) * nloc) {
            __builtin_amdgcn_fence(__ATOMIC_RELEASE, "agent");
            asm volatile("s_waitcnt vmcnt(0)" ::: "memory");
            const unsigned og = xb_add(&bar[XB_TOP], 1u);
            const unsigned tg = og / nx;
            if (og + 1u == (tg + 1u) * nx) xb_add(&bar[XB_TOPGEN], 1u);
            else XB_SPIN(xb_ld(&bar[XB_TOPGEN]) == tg, bar);
            __builtin_amdgcn_fence(__ATOMIC_ACQUIRE, "agent");
            xb_add(&bar[XB_XGEN(b.x)], 1u);
            asm volatile("s_waitcnt vmcnt(0)" ::: "memory");
        } else {
            XB_SPIN(xb_ld(&bar[XB_XGEN(b.x)]) == gen, bar);
            __builtin_amdgcn_fence(__ATOMIC_ACQUIRE, "agent");
            asm volatile("s_waitcnt vmcnt(0)" ::: "memory");
        }
    }
    __syncthreads();
}

template <int l> __device__ __forceinline__ void layer_body(const Args& a, LAS unsigned char* lds, unsigned char* ws, float* out, const float* norms, volatile LAS int* slot, const XcdBarrier& bar) {
        const float* g = norms + (size_t)l * 8 * 1024;
        { OPQ(); pg8::EpiSwiglu E{ACT, 2816}; run_gemm(lds, Abuf, WSB(WS_GU + (size_t)(l * 2 + 0) * SZ_GU), MP, 5632, 1024, E); }
        xcd_barrier(bar);
        { OPQ(); pg8::EpiRms2<false, true> E{l == 0 ? a.in[0] : (const float*)out_, out_, Abuf, nullptr, g + 1024, g + 2048, 0.5f, RSTAT(XK(0)), RSTAT(XK(0) + 1)};
          run_gemm_fused(lds, ACT, WSB(WS_DN + (size_t)(l * 2 + 0) * SZ_DN), 2816, E); }
        { OPQ(); pg8::EpiPart E{PART, 1024, 512}; run_gemm_split(lds, ACT, WSB(WS_DN + (size_t)(l * 2 + 0) * SZ_DN), 1024, 2816, 11, E); }
        xcd_barrier(bar);
        { OPQ(); if (l == 0) row_phase<true, true, true, 11>(a.in[0], a.in[1], out_, F, g + 1024, 0.5f, g + 2048, Abuf, PART, nullptr, TOK_P);
          else row_phase<false, true, true, 11>(nullptr, nullptr, out_, F, g + 1024, 0.5f, g + 2048, Abuf, PART, nullptr, TOK_P); }
        xcd_barrier(bar);
        if (l == 0) {
            { OPQ(); pg8::EpiAbIn E{out_, Q0, KVP, SKV, ropedf, OUT_SBK_P, OUT_SBK_S, 0.125f * LOG2E};
              run_gemm(lds, Abuf, WSB(WS_ABIN), MP, 3072, 1024, E); }
            xcd_barrier(bar);
            {   OPQ();
                const float* lv = a.in[19];
                int tl_ = threadIdx.x; asm volatile("" : "+v"(tl_)); const int lane = tl_ & 63;
                const float d01 = wave_sum(lv[lane] * lv[64 + lane]), d23 = wave_sum(lv[128 + lane] * lv[192 + lane]);
                const float lam = expf(d01) - expf(d23) + 0.2f;
                const size_t PSZ = (size_t)16384 * 512, SSZ = (size_t)8 * SEQS * 512;
                const int rep_ = 0;
                for (;;) {
                    const int u = next_unit(ctl + 0 + 128 * rep_, slot);
                    if (u >= 1152) break;
                    int type, qb = 0, idx;
                    if (u < 256) { type = 0; qb = 15 - u / 32; idx = u % 32; }
                    else if (u < 320) { type = 1; idx = u - 256; }
                    else if (u < 576) { type = 0; qb = 7 - (u - 320) / 32; idx = (u - 320) % 32; }
                    else if (u < 1088) { type = 2; qb = 15 - (u - 576) / 32; idx = (u - 576) % 32; }
                    else { type = 3; idx = u - 1088; }
                    const bool smp = (type & 1) != 0;
                    if (type < 2) {
                        const int comp = idx & 1, bh = idx >> 1, b = bh >> 2, h = bh & 3;
                        const size_t row0 = smp ? (size_t)TOK_P + 16 * b : (size_t)b * 4096 + 256 * qb;
                        const bf16_t* Kb = smp ? SKV + 2 * SSZ + (size_t)b * SEQS * 512 : KVP + 2 * PSZ + (size_t)b * 4096 * 512;
                        const bf16_t* Vb = smp ? SKV + 3 * SSZ + (size_t)b * SEQS * 512 : KVP + 3 * PSZ + (size_t)b * 4096 * 512;
                        attn_unit<64, 128, 0, 1>(lds, Q0 + (size_t)MP * 512 + row0 * 512 + h * 128 + comp * 64, 512, Kb + h * 128 + comp * 64, 512, nullptr, Vb + h * 128, 512,
                                                 DFO + (size_t)comp * MP * 512 + row0 * 512 + h * 128, 512, smp ? 16 : 256, smp ? 2048 : 256 * qb, smp ? 33 : 4 * qb + 4, smp ? 2064 : (1 << 30), 0.f, nullptr);
                    } else {
                        const int b = idx >> 3, h = idx & 7;
                        const size_t row0 = smp ? (size_t)TOK_P + 16 * b : (size_t)b * 4096 + 256 * qb;
                        const bf16_t* Kb = smp ? SKV + (size_t)b * SEQS * 512 : KVP + (size_t)b * 4096 * 512;
                        const bf16_t* Vb = smp ? SKV + SSZ + (size_t)b * SEQS * 512 : KVP + PSZ + (size_t)b * 4096 * 512;
                        attn_unit<64, 64, 1, 1>(lds, Q0 + row0 * 512 + h * 64, 512, Kb + h * 64, 512, nullptr, Vb + h * 64, 512,
                                                Abuf + row0 * 1024 + h * 64, 1024, smp ? 16 : 256, smp ? 2048 : 256 * qb, smp ? 33 : 4 * qb + 4, 1 << 30, 0.f, nullptr);
                    }
                }
                (void)lam;
            }
            xcd_barrier(bar);
            {
                OPQ(); int t_ = threadIdx.x; asm volatile("" : "+v"(t_));
                const int lane = t_ & 63, gw = blockIdx.x * 8 + __builtin_amdgcn_readfirstlane(t_ >> 6), ngw = gridDim.x * 8;
                const float* lv = a.in[19];
                const float d01 = wave_sum(lv[lane] * lv[64 + lane]), d23 = wave_sum(lv[128 + lane] * lv[192 + lane]);
                const float lam = expf(d01) - expf(d23) + 0.2f;
                const int sub = lane >> 4, l16 = lane & 15;
                const f32x4 sg0 = ((const f32x4*)a.in[20])[2 * l16], sg1 = ((const f32x4*)a.in[20])[2 * l16 + 1];
#pragma unroll 2
                for (int it = gw * 4 + sub; it < TOK_ALL * 4; it += ngw * 4) { const int row = it >> 2, h = it & 3;
                    const u32x4 w1 = *(const u32x4*)(DFO + (size_t)row * 512 + h * 128 + 8 * l16), w2 = *(const u32x4*)(DFO + (size_t)MP * 512 + (size_t)row * 512 + h * 128 + 8 * l16);
                    float v[8]; float ss = 0.f;
#pragma unroll
                    for (int k = 0; k < 4; ++k) {
                        v[2 * k] = __builtin_bit_cast(float, w1[k] << 16) - lam * __builtin_bit_cast(float, w2[k] << 16);
                        v[2 * k + 1] = __builtin_bit_cast(float, w1[k] & 0xffff0000u) - lam * __builtin_bit_cast(float, w2[k] & 0xffff0000u);
                        ss += v[2 * k] * v[2 * k] + v[2 * k + 1] * v[2 * k + 1]; }
                    ss += shx<1>(ss); ss += shx<2>(ss); ss += shx<4>(ss); ss += shx<8>(ss);
                    const float rn = 0.8f / sqrtf(ss * (1.f / 128.f) + EPS);
                    u32x4 o; o.x = pk2(v[0] * rn * sg0[0], v[1] * rn * sg0[1]); o.y = pk2(v[2] * rn * sg0[2], v[3] * rn * sg0[3]);
                    o.z = pk2(v[4] * rn * sg1[0], v[5] * rn * sg1[1]); o.w = pk2(v[6] * rn * sg1[2], v[7] * rn * sg1[3]);
                    *(u32x4*)(Abuf + (size_t)row * 1024 + 512 + h * 128 + 8 * l16) = o; }
            }
            xcd_barrier(bar);
            { OPQ(); pg8::EpiRms2<false, true> E{out_, out_, Abuf, nullptr, g + 3 * 1024, g + 4 * 1024, 1.0f, RSTAT(XK(1)), RSTAT(XK(1) + 1)}; run_gemm_fused(lds, Abuf, WSB(WS_ABOUT), 1024, E); }
            { OPQ(); pg8::EpiPart E{PART, 1024, 512}; run_gemm_split(lds, Abuf, WSB(WS_ABOUT), 1024, 1024, 4, E); }
        } else {
            { OPQ(); pg8::EpiF32 E{MI, 768}; run_gemm(lds, Abuf, WSB(WS_MLAIN), MP, 768, 1024, E); }
            xcd_barrier(bar);
            { OPQ(); mla_row_phase(MI, a.in[22], a.in[23], ropemla, CQ, LAT, KR, out_); }
            xcd_barrier(bar);
            { OPQ(); pg8::EpiBf16Split E{KN, VV, 1024, 1024, 1.0f}; run_gemm(lds, LAT, WSB(WS_UKV), LROWS, 2048, 256, E); }
            { OPQ(); pg8::EpiBf16Split E{Q96, Q96, 1536, 1 << 30, 0.10206207261596577f * LOG2E}; run_gemm(lds, CQ, WSB(WS_UQ), MP, 1536, 384, E); }
            xcd_barrier(bar);
            { OPQ();
            const int rep_ = 0;
            for (;;) {
                const int u = next_unit(ctl + 64 + 128 * rep_, slot);
                if (u >= 1152) break;
                bool smp = false; int qb = 0, idx;
                if (u < 512) { qb = 15 - u / 64; idx = u % 64; }
                else if (u < 640) { smp = true; idx = u - 512; }
                else { qb = 7 - (u - 640) / 64; idx = (u - 640) % 64; }
                const int b = idx >> 4, h = idx & 15;
                const size_t row0 = smp ? (size_t)TOK_P + 16 * b : (size_t)b * 4096 + 256 * qb;
                const size_t krow0 = smp ? (size_t)TOK_P + (size_t)b * SEQS : (size_t)b * 4096;
                attn_unit<96, 64, 0, 1>(lds, Q96 + row0 * 1536 + h * 96, 1536, KN + krow0 * 1024 + h * 64, 1024, KR + krow0 * 32, VV + krow0 * 1024 + h * 64, 1024,
                                        Abuf + row0 * 1024 + h * 64, 1024, smp ? 16 : 256, smp ? 2048 : 256 * qb, smp ? 33 : 4 * qb + 4, smp ? 2064 : (1 << 30), 0.f, ropemla);
            } }
            xcd_barrier(bar);
            { OPQ(); pg8::EpiRms2<false, true> E{out_, out_, Abuf, nullptr, g + 3 * 1024, g + 4 * 1024, 1.0f, RSTAT(XK(1)), RSTAT(XK(1) + 1)}; run_gemm_fused(lds, Abuf, WSB(WS_MLAOUT), 1024, E); }
            { OPQ(); pg8::EpiPart E{PART, 1024, 512}; run_gemm_split(lds, Abuf, WSB(WS_MLAOUT), 1024, 1024, 4, E); }
        }
        xcd_barrier(bar);
        { OPQ(); row_phase<false, true, true, 4>(nullptr, nullptr, out_, F, g + 3 * 1024, 1.0f, g + 4 * 1024, Abuf, PART, nullptr, TOK_P); }
        xcd_barrier(bar);
        { OPQ(); pg8::EpiSwiglu E{ACT, 2816}; run_gemm(lds, Abuf, WSB(WS_GU + (size_t)(l * 2 + 1) * SZ_GU), MP, 5632, 1024, E); }
        xcd_barrier(bar);
        { OPQ(); pg8::EpiRms2<false, true> E{out_, out_, Abuf, nullptr, g + 5 * 1024, g + 6 * 1024, 0.5f, RSTAT(XK(2)), RSTAT(XK(2) + 1)};
          run_gemm_fused(lds, ACT, WSB(WS_DN + (size_t)(l * 2 + 1) * SZ_DN), 2816, E); }
        { OPQ(); pg8::EpiPart E{PART, 1024, 512}; run_gemm_split(lds, ACT, WSB(WS_DN + (size_t)(l * 2 + 1) * SZ_DN), 1024, 2816, 11, E); }
        xcd_barrier(bar);
        { OPQ(); row_phase<false, true, true, 11>(nullptr, nullptr, out_, F, g + 5 * 1024, 0.5f, g + 6 * 1024, Abuf, PART, nullptr, TOK_P); }
        xcd_barrier(bar);
        { OPQ(); pg8::EpiF32 E{F, 1024}; run_gemm(lds, PB + (size_t)l * MP * 256, WSB(WS_PLEI + (size_t)l * SZ_PLEI), TOK_P, 1024, 256, E); }
        { OPQ(); if (l == 0) { pg8::EpiRms2<true, true> E{out_, out_, Abuf, F, g + 7 * 1024, g + 8 * 1024, 1.0f, RSTAT(XK(3)), RSTAT(XK(3) + 1)}; run_gemm_fused(lds, Abuf, WSB(WS_PLEG + (size_t)l * SZ_SQ), 1024, E); }
          else { pg8::EpiRms2<true, false> E{out_, out_, nullptr, F, g + 7 * 1024, nullptr, 1.0f, RSTAT(XK(3)), RSTAT(XK(3) + 1)}; run_gemm_fused(lds, Abuf, WSB(WS_PLEG + (size_t)l * SZ_SQ), 1024, E); } }
        { OPQ(); pg8::EpiPart E{PIN, 1024, 512}; run_gemm_split(lds, PB + (size_t)l * MP * 256, WSB(WS_PLEI + (size_t)l * SZ_PLEI), 1024, 256, 1, E); }
        { OPQ(); pg8::EpiPart E{PART, 1024, 512}; run_gemm_split(lds, Abuf, WSB(WS_PLEG + (size_t)l * SZ_SQ), 1024, 1024, 4, E); }
        xcd_barrier(bar);
        { OPQ(); if (l == 0) row_phase<false, true, true, 4, true>(nullptr, nullptr, out_, F, g + 7 * 1024, 1.0f, g + 8 * 1024, Abuf, PART, PIN, TOK_P);
          else row_phase<false, true, false, 4, true>(nullptr, nullptr, out_, F, g + 7 * 1024, 1.0f, nullptr, nullptr, PART, PIN, TOK_P); }
        if (l == 0) xcd_barrier(bar);
}

__global__ void __launch_bounds__(512) fwd_megakernel(Args a) {
    extern __shared__ __attribute__((aligned(16))) unsigned char lds_raw[];
    LAS unsigned char* lds = (LAS unsigned char*)lds_raw;
    cg::grid_group grid = cg::this_grid();
    unsigned char* ws = a.ws; float* out = a.out;
    const float* norms = a.in[10];
    volatile LAS int* slot = (volatile LAS int*)(lds + LDS_MISC);
    volatile LAS unsigned* bst = (volatile LAS unsigned*)(lds + LDS_MISC + 64);
    if (threadIdx.x < 2) bst[threadIdx.x] = 0u;
    __syncthreads();
    const XcdBarrier bar = xcd_barrier_post((unsigned*)(ws + WS_CTL) + CW_BAR, bst);

    {
        OPQ();
        int tid = threadIdx.x; asm volatile("" : "+v"(tid));
        const int lane = tid & 63, wave = __builtin_amdgcn_readfirstlane(tid >> 6);
        const int G = gridDim.x, gw = blockIdx.x * 8 + wave, ngw = G * 8;
        const long gt = (long)blockIdx.x * 512 + tid, ngt = (long)G * 512;
        LAS float* scr = (LAS float*)(lds + wave * 16384);
        int base = 0;
#define TR(MAP, src, dst, K_, N_, Nv_) do { const int items_ = ((K_) / 64) * ((Nv_) / 32); \
            for (int it_ = (gw + ngw - (base % ngw)) % ngw; it_ < items_; it_ += ngw) transpose_item<MAP>((src), (K_), (N_), (Nv_), (bf16_t*)(dst), scr, it_, lane); base += items_; } while (0)
        for (int l = 0; l < 2; ++l) {
            TR(1, a.in[11] + (size_t)l * 1024 * 5632, w_ + WS_GU + (size_t)(l * 2 + 0) * SZ_GU, 1024, 5632, 5632);
            TR(1, a.in[13] + (size_t)l * 1024 * 5632, w_ + WS_GU + (size_t)(l * 2 + 1) * SZ_GU, 1024, 5632, 5632);
            TR(0, a.in[12] + (size_t)l * 2816 * 1024, w_ + WS_DN + (size_t)(l * 2 + 0) * SZ_DN, 2816, 1024, 1024);
            TR(0, a.in[14] + (size_t)l * 2816 * 1024, w_ + WS_DN + (size_t)(l * 2 + 1) * SZ_DN, 2816, 1024, 1024);
            TR(0, a.in[16] + (size_t)l * 1024 * 1024, w_ + WS_PLEG + (size_t)l * SZ_SQ, 1024, 1024, 1024);
            TR(0, a.in[15] + (size_t)l * 256 * 1024, w_ + WS_PLEI + (size_t)l * SZ_PLEI, 256, 1024, 1024);
        }
        TR(0, a.in[17], w_ + WS_ABIN, 1024, 3072, 3072);
        TR(0, a.in[18], w_ + WS_ABOUT, 1024, 1024, 1024);
        TR(0, a.in[21], w_ + WS_MLAIN, 1024, 672, 768);
        TR(0, a.in[24], w_ + WS_UQ, 384, 1536, 1536);
        TR(0, a.in[25], w_ + WS_UKV, 256, 1024, 1024);
        TR(0, a.in[26], w_ + WS_UKV + (size_t)1024 * 256 * 2, 256, 1024, 1024);
        TR(0, a.in[27], w_ + WS_MLAOUT, 1024, 1024, 1024);
#undef TR
        cvt_rows(a.in[4], SKV + (size_t)0 * (8 * SEQS * 512), 16384, 512, 2048, SEQS, gt, ngt);
        cvt_rows(a.in[5], SKV + (size_t)1 * (8 * SEQS * 512), 16384, 512, 2048, SEQS, gt, ngt);
        cvt_rows(a.in[6], SKV + (size_t)2 * (8 * SEQS * 512), 16384, 512, 2048, SEQS, gt, ngt);
        cvt_rows(a.in[7], SKV + (size_t)3 * (8 * SEQS * 512), 16384, 512, 2048, SEQS, gt, ngt);
        cvt_rows(a.in[8], LAT + (size_t)TOK_P * 256, 16384, 256, 2048, SEQS, gt, ngt);
        cvt_rows(a.in[9], KR + (size_t)TOK_P * 32, 16384, 32, 2048, SEQS, gt, ngt);
        for (int l = 0; l < 2; ++l) {
            cvt_rows(a.in[2] + (size_t)l * 16384 * 256, PB + (size_t)l * MP * 256, 16384, 256, 1 << 30, 0, gt, ngt);
            cvt_rows(a.in[3] + (size_t)l * 128 * 256, PB + (size_t)l * MP * 256 + (size_t)TOK_P * 256, 128, 256, 1 << 30, 0, gt, ngt);
            zero_segs(PB + (size_t)l * MP * 256 + (size_t)TOK_ALL * 256, 1, 0, 128 * 256, gt, ngt);
        }
        for (int i = 0; i < 4; ++i) zero_segs(SKV + (size_t)i * (8 * SEQS * 512) + (size_t)2064 * 512, 8, (size_t)SEQS * 512, 48 * 512, gt, ngt);
        zero_segs(LAT + ((size_t)TOK_P + 2064) * 256, 8, (size_t)SEQS * 256, 48 * 256, gt, ngt);
        zero_segs(KR + ((size_t)TOK_P + 2064) * 32, 8, (size_t)SEQS * 32, 48 * 32, gt, ngt);
        zero_segs(Abuf + (size_t)TOK_ALL * 1024, 1, 0, 128 * 1024, gt, ngt);
        zero_segs(CQ + (size_t)TOK_ALL * 384, 1, 0, 128 * 384, gt, ngt);
        for (long i = gt; i < 4096 * 8; i += ngt) { const int pos = (int)(i >> 3), k = (int)(i & 7); float c, s; sincos_tab((float)pos * INV_DF[k], c, s); ropedf[pos * 16 + k] = c; ropedf[pos * 16 + 8 + k] = s; }
        for (long i = gt; i < 4096 * 16; i += ngt) { const int pos = (int)(i >> 4), k = (int)(i & 15); float c, s; sincos_tab((float)pos * INV_MLA[k], c, s); ropemla[pos * 32 + k] = c; ropemla[pos * 32 + 16 + k] = s; }
        row_phase<true, false, true>(a.in[0], a.in[1], nullptr, nullptr, nullptr, 0.f, norms, Abuf);
    }
    grid.sync();

    layer_body<0>(a, lds, ws, out, norms, slot, bar);
    layer_body<1>(a, lds, ws, out, norms, slot, bar);
}

extern "C" void kernel_launch(void* const* d_in, const int* in_sizes, int n_in, void* d_out, int out_size, void* d_ws, size_t ws_size, hipStream_t stream) {
    static int grid = 0;
    if (grid == 0) {
        if (n_in != 28 || out_size != (int)OUT_TOTAL || ws_size < WS_END) { fprintf(stderr, "kernel_launch: unexpected shapes (n_in %d out %d ws %zu need %zu)\n", n_in, out_size, ws_size, (size_t)WS_END); grid = -1; return; }
        int dev = 0, cus = 0, per_cu = 0;
        hipGetDevice(&dev); hipDeviceGetAttribute(&cus, hipDeviceAttributeMultiprocessorCount, dev);
        hipFuncSetAttribute((const void*)fwd_megakernel, hipFuncAttributeMaxDynamicSharedMemorySize, LDS_BYTES);
        hipOccupancyMaxActiveBlocksPerMultiprocessor(&per_cu, (const void*)fwd_megakernel, 512, LDS_BYTES);
        if (per_cu < 1) { fprintf(stderr, "kernel_launch: occupancy query says %d blocks per CU\n", per_cu); per_cu = 1; }
        grid = 256;
        if (cus < 256) { fprintf(stderr, "kernel_launch: needs a 256-CU device (got %d)\n", cus); grid = -1; return; }
        (void)hipGetLastError();
    }
    if (grid < 0) return;
    hipMemsetAsync((char*)d_ws + WS_CTL, 0, CTL_BYTES, stream);
    Args a{};
    for (int i = 0; i < 28; ++i) a.in[i] = (const float*)d_in[i];
    a.out = (float*)d_out; a.ws = (unsigned char*)d_ws;
    void* args[] = {&a};
    hipError_t e = hipLaunchCooperativeKernel((const void*)fwd_megakernel, dim3(grid), dim3(512), args, LDS_BYTES, stream);
    if (e != hipSuccess) fprintf(stderr, "cooperative launch failed: %s (grid %d)\n", hipGetErrorString(e), grid);
}
```
